# Optimizing an MI355X kernel written in HIP

```python
import math
import jax, jax.numpy as jnp
from jax import lax
import numpy as np

D_MODEL = 2048
BATCH = 4
SEQ = 4096
DEPTH = 1

CHUNK = 64
Q_BLOCK = 128
D_MIX = D_MODEL
A_HEADS = 8
A_DK = 64
A_DV = 2 * A_DK
A_WIDTH = A_HEADS * A_DV
B_HEADS = 4
B_WIDTH = D_MIX - A_WIDTH
B_DV = B_WIDTH // B_HEADS
B_DK = B_DV // 2
GATE_RANK = 16
GATE_TAU = 16.0
N_BUCKETS = 32
MAX_DISTANCE = 256
N_GROUPS = 4
EXPERTS_PER_GROUP = 8
N_EXPERTS = N_GROUPS * EXPERTS_PER_GROUP
TOP_K = 2
D_EXPERT = D_MODEL // 4
MOE_BLOCK = 128
EPS = 1e-6
NEG_INF = -1e30
SZ_QA = A_HEADS * 2 * A_DK
SZ_KA = A_HEADS * 2 * A_DK
SZ_VA = A_WIDTH
SZ_QB = B_HEADS * B_DK
SZ_KB = B_HEADS * B_DK
SZ_VB = B_WIDTH
SZ_RB = B_WIDTH
SZ_ZB = GATE_RANK
D_IN = SZ_QA + SZ_KA + SZ_VA + SZ_QB + SZ_KB + SZ_VB + SZ_RB + SZ_ZB
IN_SPLITS = (SZ_QA,
             SZ_QA + SZ_KA,
             SZ_QA + SZ_KA + SZ_VA,
             SZ_QA + SZ_KA + SZ_VA + SZ_QB,
             SZ_QA + SZ_KA + SZ_VA + SZ_QB + SZ_KB,
             SZ_QA + SZ_KA + SZ_VA + SZ_QB + SZ_KB + SZ_VB,
             SZ_QA + SZ_KA + SZ_VA + SZ_QB + SZ_KB + SZ_VB + SZ_RB)

kernel_name = "hybrid_diffattn_gla_hmoe_block"


def rms_norm(x, g):
    xf = x.astype(jnp.float32)
    y = xf * lax.rsqrt(jnp.mean(xf * xf, axis=-1, keepdims=True) + EPS)
    return (y * g.astype(jnp.float32)).astype(x.dtype)


def t5_bucket(rel):
    nb = N_BUCKETS // 2
    max_exact = nb // 2
    base = jnp.where(rel > 0, nb, 0)
    n = jnp.abs(rel)
    nf = jnp.maximum(n, 1).astype(jnp.float32)
    large = max_exact + (jnp.log(nf / max_exact) / math.log(MAX_DISTANCE / max_exact)
                         * (nb - max_exact)).astype(jnp.int32)
    large = jnp.minimum(large, nb - 1)
    return base + jnp.where(n < max_exact, n, large)


def diff_attention(q, k, v, rel_bias, lam, sub_gain, lam_init):
    Bn, S = q.shape[0], q.shape[1]
    nblk = S // Q_BLOCK
    qb = (q * (A_DK ** -0.5)).reshape(Bn, nblk, Q_BLOCK, A_HEADS, 2, A_DK)
    qb = qb.transpose(1, 0, 3, 4, 2, 5)
    kt = k.transpose(0, 2, 3, 1, 4)
    vt = v.transpose(0, 2, 1, 3)
    kpos = jnp.arange(S)

    def block(args):
        blk, qblk = args
        qpos = blk * Q_BLOCK + jnp.arange(Q_BLOCK)
        rel = kpos[None, :] - qpos[:, None]
        bias = rel_bias[t5_bucket(rel)].transpose(2, 0, 1)
        allowed = (kpos[None, :] // CHUNK) <= (qpos[:, None] // CHUNK)
        s = jnp.einsum('bhmqd,bhmkd->bhmqk', qblk, kt).astype(jnp.float32)
        s = s + bias[None, :, None].astype(jnp.float32)
        s = jnp.where(allowed, s, NEG_INF)
        p = jax.nn.softmax(s, axis=-1)
        pd = p[:, :, 0] - lam * p[:, :, 1]
        return jnp.einsum('bhqk,bhkd->bhqd', pd.astype(v.dtype), vt)

    o = lax.map(block, (jnp.arange(nblk), qb))
    o = o.transpose(1, 0, 3, 2, 4).reshape(Bn, S, A_HEADS, A_DV)
    o = rms_norm(o, sub_gain) * (1.0 - lam_init)
    return o.reshape(Bn, S, A_WIDTH)


def gla(q, k, v, log_a):
    Bn, S = q.shape[0], q.shape[1]
    nc = S // CHUNK

    def to_chunks(t):
        return t.reshape(Bn, nc, CHUNK, B_HEADS, t.shape[-1]).transpose(1, 0, 3, 2, 4).astype(jnp.float32)

    qc = to_chunks(q * (B_DK ** -0.5))
    kc = to_chunks(k)
    vc = to_chunks(v)
    ac = to_chunks(log_a)

    def step(state, inp):
        qn, kn, vn, an = inp
        cum = jnp.cumsum(an, axis=2)
        total = cum[:, :, -1:]
        k_dec = kn * jnp.exp(total - cum)
        state = jnp.exp(total[:, :, 0])[..., None] * state + jnp.einsum('bhcd,bhce->bhde', k_dec, vn)
        return state, jnp.einsum('bhcd,bhde->bhce', qn, state)

    s0 = jnp.zeros((Bn, B_HEADS, B_DK, B_DV), jnp.float32)
    _, o = lax.scan(step, s0, (qc, kc, vc, ac))
    return o.transpose(1, 0, 3, 2, 4).reshape(Bn, S, B_HEADS, B_DV).astype(v.dtype)


def token_mixer(h, rel_bias, w_in, w_alpha, b_alpha, lam_q1, lam_k1, lam_q2, lam_k2,
                g_sub_a, g_norm_b, w_out, lam_init):
    Bn, S = h.shape[0], h.shape[1]
    proj = h @ w_in
    qa, ka, va, qb, kb, vb, rb, zb = jnp.split(proj, IN_SPLITS, axis=-1)
    lam = (jnp.exp(jnp.dot(lam_q1.astype(jnp.float32), lam_k1.astype(jnp.float32)))
           - jnp.exp(jnp.dot(lam_q2.astype(jnp.float32), lam_k2.astype(jnp.float32))) + lam_init)
    oa = diff_attention(qa.reshape(Bn, S, A_HEADS, 2, A_DK),
                        ka.reshape(Bn, S, A_HEADS, 2, A_DK),
                        va.reshape(Bn, S, A_HEADS, A_DV),
                        rel_bias, lam, g_sub_a, lam_init)
    log_a = jax.nn.log_sigmoid((zb @ w_alpha + b_alpha).astype(jnp.float32)) / GATE_TAU
    ob = gla(qb.reshape(Bn, S, B_HEADS, B_DK),
             kb.reshape(Bn, S, B_HEADS, B_DK),
             vb.reshape(Bn, S, B_HEADS, B_DV),
             log_a.reshape(Bn, S, B_HEADS, B_DK))
    ob = rms_norm(ob, g_norm_b).reshape(Bn, S, B_WIDTH) * jax.nn.silu(rb)
    return jnp.concatenate([oa, ob], axis=-1) @ w_out


def hier_moe(h, w_rg, b_rg, w_re, b_re, w1, w3, w2):
    Bn, S, D = h.shape
    g_prob = jax.nn.softmax((h @ w_rg + b_rg).astype(jnp.float32), axis=-1)
    g_val, g_idx = lax.top_k(g_prob, 1)
    e_logit = (h @ w_re + b_re).astype(jnp.float32).reshape(Bn, S, N_GROUPS, EXPERTS_PER_GROUP)
    sel = jax.nn.one_hot(g_idx[..., 0], N_GROUPS, dtype=jnp.float32)
    e_logit = jnp.einsum('bsg,bsge->bse', sel, e_logit)
    e_prob = jax.nn.softmax(e_logit, axis=-1)
    e_val, e_idx = lax.top_k(e_prob, TOP_K)
    e_val = e_val / jnp.sum(e_val, axis=-1, keepdims=True)
    weights = g_val * e_val
    expert_id = g_idx * EXPERTS_PER_GROUP + e_idx
    combine = jnp.sum(jax.nn.one_hot(expert_id, N_EXPERTS, dtype=jnp.float32) * weights[..., None], axis=2)

    nblk = S // MOE_BLOCK
    tb = h.reshape(Bn, nblk, MOE_BLOCK, D).transpose(1, 0, 2, 3).reshape(nblk, Bn * MOE_BLOCK, D)
    cb = combine.reshape(Bn, nblk, MOE_BLOCK, N_EXPERTS).transpose(1, 0, 2, 3).reshape(nblk, Bn * MOE_BLOCK, N_EXPERTS)

    def block(args):
        t, cw = args
        a = jnp.einsum('td,edf->tef', t, w1)
        b = jnp.einsum('td,edf->tef', t, w3)
        hid = jax.nn.silu(a) * b * cw[:, :, None].astype(t.dtype)
        return jnp.einsum('tef,efd->td', hid, w2)

    y = lax.map(block, (tb, cb))
    return y.reshape(nblk, Bn, MOE_BLOCK, D).transpose(1, 0, 2, 3).reshape(Bn, S, D)


def setup_inputs(seed: int = 0) -> dict:
    key = jax.random.key(seed)
    ks = jax.random.split(key, 26)
    f32 = jnp.float32
    nrm = lambda k, shape, s: jax.random.normal(k, shape, f32) * s
    gain = lambda k, shape: 1.0 + 0.05 * jax.random.normal(k, shape, f32)
    D, L = D_MODEL, DEPTH
    return {
        "x": nrm(ks[0], (BATCH, SEQ, D), 1.0),
        "c": nrm(ks[1], (BATCH, D), 1.0),
        "rel_bias": nrm(ks[2], (N_BUCKETS, A_HEADS), 0.5),
        "w_ada": nrm(ks[3], (L, D, 6 * D), 0.5 * D ** -0.5),
        "b_ada": nrm(ks[4], (L, 6 * D), 0.02),
        "g_pre_mix": gain(ks[5], (L, D)),
        "g_post_mix": gain(ks[6], (L, D)),
        "w_in": nrm(ks[7], (L, D, D_IN), D ** -0.5),
        "w_alpha": nrm(ks[8], (L, GATE_RANK, B_HEADS * B_DK), GATE_RANK ** -0.5),
        "b_alpha": nrm(ks[9], (L, B_HEADS * B_DK), 0.1),
        "lam_q1": nrm(ks[10], (L, A_DK), 0.1),
        "lam_k1": nrm(ks[11], (L, A_DK), 0.1),
        "lam_q2": nrm(ks[12], (L, A_DK), 0.1),
        "lam_k2": nrm(ks[13], (L, A_DK), 0.1),
        "g_sub_a": gain(ks[14], (L, A_DV)),
        "g_norm_b": gain(ks[15], (L, B_DV)),
        "w_out": nrm(ks[16], (L, D_MIX, D), D_MIX ** -0.5),
        "g_pre_ffn": gain(ks[17], (L, D)),
        "g_post_ffn": gain(ks[18], (L, D)),
        "w_router_g": nrm(ks[19], (L, D, N_GROUPS), D ** -0.5),
        "b_router_g": nrm(ks[20], (L, N_GROUPS), 0.01),
        "w_router_e": nrm(ks[21], (L, D, N_EXPERTS), D ** -0.5),
        "b_router_e": nrm(ks[22], (L, N_EXPERTS), 0.01),
        "w1": nrm(ks[23], (L, N_EXPERTS, D, D_EXPERT), D ** -0.5),
        "w3": nrm(ks[24], (L, N_EXPERTS, D, D_EXPERT), D ** -0.5),
        "w2": nrm(ks[25], (L, N_EXPERTS, D_EXPERT, D), D_EXPERT ** -0.5),
    }


def reference(x, c, rel_bias, w_ada, b_ada, g_pre_mix, g_post_mix, w_in, w_alpha, b_alpha,
              lam_q1, lam_k1, lam_q2, lam_k2, g_sub_a, g_norm_b, w_out, g_pre_ffn, g_post_ffn,
              w_router_g, b_router_g, w_router_e, b_router_e, w1, w3, w2):
    for i in range(DEPTH):
        lam_init = 0.8 - 0.6 * math.exp(-0.3 * i)
        ada = jax.nn.silu(c) @ w_ada[i] + b_ada[i]
        sh_m, sc_m, gt_m, sh_f, sc_f, gt_f = [a[:, None, :] for a in jnp.split(ada, 6, axis=-1)]
        h = rms_norm(x, g_pre_mix[i]) * (1 + sc_m) + sh_m
        y = token_mixer(h, rel_bias, w_in[i], w_alpha[i], b_alpha[i], lam_q1[i], lam_k1[i],
                        lam_q2[i], lam_k2[i], g_sub_a[i], g_norm_b[i], w_out[i], lam_init)
        x = x + gt_m * rms_norm(y, g_post_mix[i])
        h = rms_norm(x, g_pre_ffn[i]) * (1 + sc_f) + sh_f
        y = hier_moe(h, w_router_g[i], b_router_g[i], w_router_e[i], b_router_e[i], w1[i], w3[i], w2[i])
        x = x + gt_f * rms_norm(y, g_post_ffn[i])
    return x
```

```cpp
#include <hip/hip_runtime.h>
#include <cstdio>
#include <cstdint>

typedef unsigned short bf16;
typedef short bf16x8 __attribute__((ext_vector_type(8)));
typedef float f32x4 __attribute__((ext_vector_type(4)));
typedef unsigned u32x2 __attribute__((ext_vector_type(2)));
typedef unsigned u32x4 __attribute__((ext_vector_type(4)));

constexpr int BATCH = 4, SEQ = 4096, DM = 2048, M = BATCH * SEQ;
constexpr int D_IN = 6160, NPROJ = 6144;
constexpr int NADA = 6 * DM;
constexpr int NEXP = 32, DEXP = 512, LISTCAP = M;
constexpr float EPS = 1e-6f;
constexpr float LOG2E = 1.4426950408889634f;
constexpr float QA_SCALE = 0.125f * LOG2E;
constexpr float QB_SCALE = 0.08838834764831845f;
constexpr float LAM_INIT = 0.2f;
constexpr int C_QA = 0, C_KA = 1024, C_VA = 2048, C_QB = 3072, C_KB = 3584, C_VB = 4096, C_RB = 5120;

constexpr size_t MiB = 1u << 20;
constexpr size_t WS_CTL = 0;
constexpr size_t WS_ADAP = 1 * MiB;
constexpr size_t WS_ZB = 2 * MiB;
constexpr size_t WS_LIST = 3 * MiB;
constexpr size_t WS_LW = 5 * MiB;
constexpr size_t WS_WIN = 8 * MiB;
constexpr size_t WS_WOUT = 32 * MiB;
constexpr size_t WS_WUP = 40 * MiB;
constexpr size_t WS_WDN = 168 * MiB;
constexpr size_t WS_H = 232 * MiB;
constexpr size_t WS_CAT = 296 * MiB;
constexpr size_t WS_PROJ = 360 * MiB;
constexpr size_t WS_Y2 = WS_PROJ;
constexpr size_t WS_HID = WS_PROJ + 128 * MiB;
constexpr size_t WS_END = 552 * MiB;
constexpr size_t WS_Y = WS_H, WS_H2 = WS_CAT;
constexpr int HID_ROWS = 41216;

__device__ __forceinline__ unsigned f2bf(float f) { unsigned u = __float_as_uint(f); return (u + 0x7fffu + ((u >> 16) & 1u)) >> 16; }
__device__ __forceinline__ float bf2f(unsigned b) { return __uint_as_float(b << 16); }
__device__ __forceinline__ unsigned pk2(float lo, float hi) { return f2bf(lo) | (f2bf(hi) << 16); }
__device__ __forceinline__ float wave_sum(float v) {
#pragma unroll
    for (int o = 1; o < 64; o <<= 1) v += __shfl_xor(v, o);
    return v;
}
__device__ __forceinline__ float siluf(float x) { return x / (1.f + __expf(-x)); }

__global__ __launch_bounds__(256) void k_ada(const float* __restrict__ c, const float* __restrict__ w_ada, float* __restrict__ part) {
    const int j = blockIdx.x * 256 + threadIdx.x, kq = blockIdx.y;
    float acc[4] = {0.f, 0.f, 0.f, 0.f};
    for (int k = kq * 512; k < kq * 512 + 512; ++k) {
        const float w = w_ada[(size_t)k * NADA + j];
#pragma unroll
        for (int b = 0; b < 4; ++b) { const float cv = c[b * DM + k]; acc[b] += siluf(cv) * w; }
    }
#pragma unroll
    for (int b = 0; b < 4; ++b) part[(size_t)(kq * 4 + b) * NADA + j] = acc[b];
}
__device__ __forceinline__ float ada_get(const float* part, const float* b_ada, int b, int j) {
    float s = b_ada[j];
#pragma unroll
    for (int kq = 0; kq < 4; ++kq) s += part[(size_t)(kq * 4 + b) * NADA + j];
    return s;
}
__device__ __forceinline__ f32x4 ada_get4(const float* part, const float* b_ada, int b, int j) {
    f32x4 s = *(const f32x4*)(b_ada + j);
#pragma unroll
    for (int kq = 0; kq < 4; ++kq) s += *(const f32x4*)(part + (size_t)(kq * 4 + b) * NADA + j);
    return s;
}

__global__ __launch_bounds__(256) void k_transpose(const float* __restrict__ W, int K, int ldw, size_t w_zstride, bf16* __restrict__ WT, int rs_hi, int off, size_t wt_zstride) {
    __shared__ float t[32][33];
    const int k0 = blockIdx.y * 32, n0 = blockIdx.x * 32, tx = threadIdx.x & 31, ty = threadIdx.x >> 5;
    W += (size_t)blockIdx.z * w_zstride; WT += (size_t)blockIdx.z * wt_zstride;
    for (int i = ty; i < 32; i += 8) t[i][tx] = W[(size_t)(k0 + i) * ldw + n0 + tx];
    __syncthreads();
    for (int i = ty; i < 32; i += 8) { const int n = n0 + i, row = (n >> 7) * rs_hi + off + (n & 127); WT[(size_t)row * K + k0 + tx] = (bf16)f2bf(t[tx][i]); }
}

__global__ __launch_bounds__(256) void k_prenorm(const float* __restrict__ x, const float* __restrict__ g, const float* __restrict__ part, const float* __restrict__ b_ada,
                                                 const float* __restrict__ w_in, bf16* __restrict__ H, float* __restrict__ ZB) {
    const int lane = threadIdx.x & 63, m = blockIdx.x * 4 + (threadIdx.x >> 6), b = m / SEQ;
    const float* xr = x + (size_t)m * DM;
    float ss = 0.f;
#pragma unroll
    for (int j = 0; j < 8; ++j) { const f32x4 v = *(const f32x4*)(xr + 256 * j + 4 * lane); ss += v.x * v.x + v.y * v.y + v.z * v.z + v.w * v.w; }
    const float r = rsqrtf(wave_sum(ss) * (1.f / DM) + EPS);
    float zacc[16];
#pragma unroll
    for (int c = 0; c < 16; ++c) zacc[c] = 0.f;
#pragma unroll 1
    for (int j = 0; j < 8; ++j) {
        const int col = 256 * j + 4 * lane;
        const f32x4 v = *(const f32x4*)(xr + col);
        const f32x4 gg = *(const f32x4*)(g + col), sh = ada_get4(part, b_ada, b, col), sc = ada_get4(part, b_ada, b, DM + col);
        f32x4 h = v * r * gg * (sc + 1.f) + sh;
        u32x2 o; o.x = pk2(h.x, h.y); o.y = pk2(h.z, h.w);
        *(u32x2*)(H + (size_t)m * DM + col) = o;
#pragma unroll
        for (int i = 0; i < 4; ++i) {
            const float hv = h[i]; const float* wz = w_in + (size_t)(col + i) * D_IN + NPROJ;
#pragma unroll
            for (int c4 = 0; c4 < 4; ++c4) { const f32x4 w = *(const f32x4*)(wz + 4 * c4); zacc[4 * c4] += hv * w.x; zacc[4 * c4 + 1] += hv * w.y; zacc[4 * c4 + 2] += hv * w.z; zacc[4 * c4 + 3] += hv * w.w; }
        }
    }
#pragma unroll
    for (int c = 0; c < 16; ++c) { const float s = wave_sum(zacc[c]); if (lane == c) ZB[(size_t)m * 16 + c] = s; }
}

template <int EPI  > __global__ __launch_bounds__(256) void k_gemm_naive(const bf16* __restrict__ A, const bf16* __restrict__ Bt, int Mr, int N, int K, bf16* __restrict__ C, int ldc) {
    const int lane = threadIdx.x & 63, i = lane & 15, g = lane >> 4;
    const int gw = blockIdx.x * 4 + (threadIdx.x >> 6), ntn = N / 32, tm = gw / ntn, tn = gw % ntn;
    if (tm * 32 >= Mr) return;
    f32x4 acc[2][2];
#pragma unroll
    for (int a = 0; a < 2; ++a)
#pragma unroll
        for (int b = 0; b < 2; ++b) acc[a][b] = (f32x4){0.f, 0.f, 0.f, 0.f};
    const bf16* ap = A + (size_t)(tm * 32 + i) * K + 8 * g;
    const bf16* bp = Bt + (size_t)(tn * 32 + i) * K + 8 * g;
    for (int k0 = 0; k0 < K; k0 += 32) {
        bf16x8 af[2], bfr[2];
#pragma unroll
        for (int r = 0; r < 2; ++r) { af[r] = *(const bf16x8*)(ap + (size_t)16 * r * K + k0); bfr[r] = *(const bf16x8*)(bp + (size_t)16 * r * K + k0); }
#pragma unroll
        for (int a = 0; a < 2; ++a)
#pragma unroll
            for (int b = 0; b < 2; ++b) acc[a][b] = __builtin_amdgcn_mfma_f32_16x16x32_bf16(af[a], bfr[b], acc[a][b], 0, 0, 0);
    }
#pragma unroll
    for (int a = 0; a < 2; ++a)
#pragma unroll
        for (int b = 0; b < 2; ++b) {
            const int col = tn * 32 + 16 * b + i; float sc = 1.f;
            if (EPI == 1) { if (col < C_KA) sc = QA_SCALE; else if (col >= C_QB && col < C_KB) sc = QB_SCALE; }
#pragma unroll
            for (int r = 0; r < 4; ++r) C[(size_t)(tm * 32 + 16 * a + 4 * g + r) * ldc + col] = (bf16)f2bf(acc[a][b][r] * sc);
        }
}

__device__ __forceinline__ int t5_bucket(int rel) {
    const int n = rel < 0 ? -rel : rel; const float nf = (float)(n > 1 ? n : 1);
    int large = 8 + (int)(logf(nf / 8.0f) / 3.4657359027997265f * 8.0f); large = large < 15 ? large : 15;
    return (rel > 0 ? 16 : 0) + (n < 8 ? n : large);
}

__global__ __launch_bounds__(64) void k_attn_naive(const bf16* __restrict__ P, const float* __restrict__ rel_bias, const float* __restrict__ lq1, const float* __restrict__ lk1,
                                                   const float* __restrict__ lq2, const float* __restrict__ lk2, const float* __restrict__ g_sub, bf16* __restrict__ CAT) {
    __shared__ float tab[320];
    const int blk = blockIdx.x, chunk = blk & 63, h = (blk >> 6) & 7, b = blk >> 9, lane = threadIdx.x;
    for (int t = lane; t < 320; t += 64) tab[t] = rel_bias[t5_bucket(t - 256) * 8 + h] * LOG2E;
    __syncthreads();
    float d1 = 0.f, d2 = 0.f;
    for (int t = 0; t < 64; ++t) { d1 += lq1[t] * lk1[t]; d2 += lq2[t] * lk2[t]; }
    const float lam = __expf(d1) - __expf(d2) + LAM_INIT;
    const int q = chunk * 64 + lane; const size_t row = (size_t)b * SEQ + q;
    const int nk = (chunk + 1) * 64;
    float o1[128];
#pragma unroll
    for (int d = 0; d < 128; ++d) o1[d] = 0.f;
    for (int mp = 0; mp < 2; ++mp) {
        float qv[64];
        { const bf16* qp = P + row * NPROJ + C_QA + h * 128 + mp * 64;
#pragma unroll
          for (int d8 = 0; d8 < 8; ++d8) { const u32x4 w = *(const u32x4*)(qp + 8 * d8);
#pragma unroll
              for (int e = 0; e < 4; ++e) { qv[8 * d8 + 2 * e] = bf2f(w[e] & 0xffffu); qv[8 * d8 + 2 * e + 1] = bf2f(w[e] >> 16); } } }
        float o[128];
#pragma unroll
        for (int d = 0; d < 128; ++d) o[d] = 0.f;
        float mrun = -1e30f, l = 0.f;
        for (int k = 0; k < nk; ++k) {
            const bf16* kp = P + ((size_t)b * SEQ + k) * NPROJ + C_KA + h * 128 + mp * 64;
            const bf16* vp = P + ((size_t)b * SEQ + k) * NPROJ + C_VA + h * 128;
            float s = 0.f;
#pragma unroll
            for (int d8 = 0; d8 < 8; ++d8) { const u32x4 w = *(const u32x4*)(kp + 8 * d8);
#pragma unroll
                for (int e = 0; e < 4; ++e) { s += qv[8 * d8 + 2 * e] * bf2f(w[e] & 0xffffu); s += qv[8 * d8 + 2 * e + 1] * bf2f(w[e] >> 16); } }
            int rel = k - q; rel = rel < -256 ? -256 : rel;
            s += tab[rel + 256];
            if (s > mrun) { const float al = exp2f(mrun - s); l *= al;
#pragma unroll
                for (int d = 0; d < 128; ++d) o[d] *= al;
                mrun = s; }
            const float p = exp2f(s - mrun); l += p;
#pragma unroll
            for (int d8 = 0; d8 < 16; ++d8) { const u32x4 w = *(const u32x4*)(vp + 8 * d8);
#pragma unroll
                for (int e = 0; e < 4; ++e) { o[8 * d8 + 2 * e] += p * bf2f(w[e] & 0xffffu); o[8 * d8 + 2 * e + 1] += p * bf2f(w[e] >> 16); } }
        }
        const float il = 1.f / l;
        if (mp == 0) {
#pragma unroll
            for (int d = 0; d < 128; ++d) o1[d] = o[d] * il;
        } else {
#pragma unroll
            for (int d = 0; d < 128; ++d) o1[d] = o1[d] - lam * (o[d] * il);
        }
    }
    float ss = 0.f;
#pragma unroll
    for (int d = 0; d < 128; ++d) ss += o1[d] * o1[d];
    const float r = rsqrtf(ss * (1.f / 128.f) + EPS) * (1.f - LAM_INIT);
    bf16* op = CAT + row * DM + h * 128;
#pragma unroll
    for (int d8 = 0; d8 < 16; ++d8) { u32x4 w;
#pragma unroll
        for (int e = 0; e < 4; ++e) w[e] = pk2(o1[8 * d8 + 2 * e] * r * g_sub[8 * d8 + 2 * e], o1[8 * d8 + 2 * e + 1] * r * g_sub[8 * d8 + 2 * e + 1]);
        *(u32x4*)(op + 8 * d8) = w; }
}

__device__ __forceinline__ float logsigmoidf(float x) { return fminf(x, 0.f) - log1pf(__expf(-fabsf(x))); }
__global__ __launch_bounds__(256) void k_gla_naive(const bf16* __restrict__ P, const float* __restrict__ ZB, const float* __restrict__ w_alpha, const float* __restrict__ b_alpha,
                                                   const float* __restrict__ g_norm_b, bf16* __restrict__ CAT) {
    __shared__ float A[64][128];
    __shared__ float tot[128];
    __shared__ float pss[4][64];
    const int b = blockIdx.x >> 2, hb = blockIdx.x & 3, tid = threadIdx.x, e = tid, lane = tid & 63, wv = tid >> 6;
    float S[128];
#pragma unroll
    for (int d = 0; d < 128; ++d) S[d] = 0.f;
    const float gn = g_norm_b[e];
    for (int n = 0; n < 64; ++n) {
        const size_t t0 = (size_t)b * SEQ + n * 64;
        for (int idx = tid; idx < 8192; idx += 256) { const int c = idx >> 7, d = idx & 127;
            float pre = b_alpha[hb * 128 + d];
#pragma unroll
            for (int k = 0; k < 16; ++k) pre += ZB[(t0 + c) * 16 + k] * w_alpha[k * 512 + hb * 128 + d];
            A[c][d] = logsigmoidf(pre) * (1.f / 16.f); }
        __syncthreads();
        if (tid < 128) { float run = 0.f; for (int c = 0; c < 64; ++c) { run += A[c][tid]; A[c][tid] = run; } tot[tid] = run; }
        __syncthreads();
        for (int idx = tid; idx < 8192; idx += 256) { const int c = idx >> 7, d = idx & 127;
            A[c][d] = bf2f(P[(t0 + c) * NPROJ + C_KB + hb * 128 + d]) * __expf(tot[d] - A[c][d]); }
        __syncthreads();
#pragma unroll
        for (int d = 0; d < 128; ++d) S[d] *= __expf(tot[d]);
        for (int c = 0; c < 64; ++c) { const float vv = bf2f(P[(t0 + c) * NPROJ + C_VB + hb * 256 + e]);
#pragma unroll
            for (int d = 0; d < 128; ++d) S[d] += A[c][d] * vv; }
#pragma unroll 1
        for (int c = 0; c < 64; ++c) { const bf16* qp = P + (t0 + c) * NPROJ + C_QB + hb * 128; float acc = 0.f;
#pragma unroll
            for (int d8 = 0; d8 < 16; ++d8) { const u32x4 w = *(const u32x4*)(qp + 8 * d8);
#pragma unroll
                for (int ee = 0; ee < 4; ++ee) { acc += bf2f(w[ee] & 0xffffu) * S[8 * d8 + 2 * ee]; acc += bf2f(w[ee] >> 16) * S[8 * d8 + 2 * ee + 1]; } }
            const float s = wave_sum(acc * acc); if (lane == 0) pss[wv][c] = s; }
        __syncthreads();
#pragma unroll 1
        for (int c = 0; c < 64; ++c) { const bf16* qp = P + (t0 + c) * NPROJ + C_QB + hb * 128; float acc = 0.f;
#pragma unroll
            for (int d8 = 0; d8 < 16; ++d8) { const u32x4 w = *(const u32x4*)(qp + 8 * d8);
#pragma unroll
                for (int ee = 0; ee < 4; ++ee) { acc += bf2f(w[ee] & 0xffffu) * S[8 * d8 + 2 * ee]; acc += bf2f(w[ee] >> 16) * S[8 * d8 + 2 * ee + 1]; } }
            const float ss = pss[0][c] + pss[1][c] + pss[2][c] + pss[3][c]; const float r = rsqrtf(ss * (1.f / 256.f) + EPS);
            const float rb = bf2f(P[(t0 + c) * NPROJ + C_RB + hb * 256 + e]);
            CAT[(t0 + c) * DM + 1024 + hb * 256 + e] = (bf16)f2bf(acc * r * gn * siluf(rb)); }
        __syncthreads();
    }
}

__device__ __forceinline__ f32x4 ld_bf4(const bf16* p) { const u32x2 w = *(const u32x2*)p; return (f32x4){bf2f(w.x & 0xffffu), bf2f(w.x >> 16), bf2f(w.y & 0xffffu), bf2f(w.y >> 16)}; }
__global__ __launch_bounds__(256) void k_mid(const float* __restrict__ x, const bf16* __restrict__ Y, const float* __restrict__ g_post, const float* __restrict__ g_pre, const float* __restrict__ part, const float* __restrict__ b_ada,
                                             const float* __restrict__ w_rg, const float* __restrict__ b_rg, const float* __restrict__ w_re, const float* __restrict__ b_re,
                                             float* out, bf16* __restrict__ H2, unsigned* __restrict__ cnt, unsigned* __restrict__ list, float* __restrict__ lw) {
    __shared__ float lg[4][40];
    const int lane = threadIdx.x & 63, wv = threadIdx.x >> 6, m = blockIdx.x * 4 + wv, b = m / SEQ;
    float ss = 0.f;
#pragma unroll
    for (int j = 0; j < 8; ++j) { const f32x4 yv = ld_bf4(Y + (size_t)m * DM + 256 * j + 4 * lane); ss += yv.x * yv.x + yv.y * yv.y + yv.z * yv.z + yv.w * yv.w; }
    const float ry = rsqrtf(wave_sum(ss) * (1.f / DM) + EPS);
    float ss2 = 0.f;
#pragma unroll 1
    for (int j = 0; j < 8; ++j) { const int col = 256 * j + 4 * lane; const f32x4 gp = *(const f32x4*)(g_post + col), gt = ada_get4(part, b_ada, b, 2 * DM + col);
        const f32x4 yv = ld_bf4(Y + (size_t)m * DM + col); f32x4 xv = *(const f32x4*)(x + (size_t)m * DM + col);
        xv = xv + gt * (yv * ry * gp); *(f32x4*)(out + (size_t)m * DM + col) = xv;
        ss2 += xv.x * xv.x + xv.y * xv.y + xv.z * xv.z + xv.w * xv.w; }
    const float rx = rsqrtf(wave_sum(ss2) * (1.f / DM) + EPS);
    float la[36];
#pragma unroll
    for (int n = 0; n < 36; ++n) la[n] = 0.f;
#pragma unroll 1
    for (int j = 0; j < 8; ++j) { const int col = 256 * j + 4 * lane; const f32x4 gp = *(const f32x4*)(g_pre + col), sh = ada_get4(part, b_ada, b, 3 * DM + col), sc = ada_get4(part, b_ada, b, 4 * DM + col);
        const f32x4 xv = *(const f32x4*)(out + (size_t)m * DM + col);
        const f32x4 h = xv * rx * gp * (sc + 1.f) + sh;
        u32x2 o; o.x = pk2(h.x, h.y); o.y = pk2(h.z, h.w); *(u32x2*)(H2 + (size_t)m * DM + col) = o;
#pragma unroll
        for (int i = 0; i < 4; ++i) { const float hv = h[i]; const f32x4 wg = *(const f32x4*)(w_rg + (size_t)(col + i) * 4);
            la[0] += hv * wg.x; la[1] += hv * wg.y; la[2] += hv * wg.z; la[3] += hv * wg.w;
#pragma unroll
            for (int c4 = 0; c4 < 8; ++c4) { const f32x4 w = *(const f32x4*)(w_re + (size_t)(col + i) * 32 + 4 * c4); la[4 + 4 * c4] += hv * w.x; la[5 + 4 * c4] += hv * w.y; la[6 + 4 * c4] += hv * w.z; la[7 + 4 * c4] += hv * w.w; } } }
#pragma unroll
    for (int n = 0; n < 36; ++n) { const float s = wave_sum(la[n]); if (lane == n) lg[wv][n] = s + (n < 4 ? b_rg[n] : b_re[n - 4]); }
    __syncthreads();
    if (lane == 0) {
        const float* L = lg[wv];
        int gi = 0; float gm = L[0];
        for (int i = 1; i < 4; ++i) if (L[i] > gm) { gm = L[i]; gi = i; }
        float gs = 0.f; for (int i = 0; i < 4; ++i) gs += __expf(L[i] - gm);
        const float gval = 1.f / gs;
        const float* E = L + 4 + 8 * gi;
        int e1 = 0; float m1 = E[0];
        for (int i = 1; i < 8; ++i) if (E[i] > m1) { m1 = E[i]; e1 = i; }
        int e2 = -1; float m2 = -3.0e38f;
        for (int i = 0; i < 8; ++i) if (i != e1 && E[i] > m2) { m2 = E[i]; e2 = i; }
        const float p2 = __expf(m2 - m1), inv = 1.f / (1.f + p2);
        const unsigned ea = (unsigned)(gi * 8 + e1), eb = (unsigned)(gi * 8 + e2);
        const unsigned pa = atomicAdd(&cnt[ea], 1u); list[(size_t)ea * LISTCAP + pa] = (unsigned)(m * 2); lw[(size_t)ea * LISTCAP + pa] = gval * inv;
        const unsigned pb = atomicAdd(&cnt[eb], 1u); list[(size_t)eb * LISTCAP + pb] = (unsigned)(m * 2 + 1); lw[(size_t)eb * LISTCAP + pb] = gval * p2 * inv;
    }
}

__device__ __forceinline__ unsigned hid_off(const unsigned* cnt, int e) { unsigned o = 0; for (int i = 0; i < e; ++i) o += (cnt[i] + 255u) & ~255u; return o; }
__global__ __launch_bounds__(64) void k_moe_up_naive(const bf16* __restrict__ H2, const bf16* __restrict__ Wup, const unsigned* __restrict__ cnt, const unsigned* __restrict__ list, const float* __restrict__ lw, bf16* __restrict__ HID) {
    const int e = blockIdx.z, rt = blockIdx.y, ct = blockIdx.x, lane = threadIdx.x, i = lane & 15, g = lane >> 4;
    const int n = (int)cnt[e]; if (rt * 32 >= n) return;
    const unsigned ho = hid_off(cnt, e);
    const bf16* ap[2]; const bf16* b1p[2]; const bf16* b3p[2];
#pragma unroll
    for (int r = 0; r < 2; ++r) { int slot = rt * 32 + 16 * r + i; slot = slot < n ? slot : n - 1; const unsigned tok = list[(size_t)e * LISTCAP + slot] >> 1; ap[r] = H2 + (size_t)tok * DM + 8 * g;
        const int f = ct * 32 + 16 * r + i, n1 = 256 * (f >> 7) + (f & 127); b1p[r] = Wup + ((size_t)e * 1024 + n1) * DM + 8 * g; b3p[r] = b1p[r] + (size_t)128 * DM; }
    f32x4 aa[2][2], ab[2][2];
#pragma unroll
    for (int a = 0; a < 2; ++a)
#pragma unroll
        for (int b = 0; b < 2; ++b) { aa[a][b] = (f32x4){0.f, 0.f, 0.f, 0.f}; ab[a][b] = (f32x4){0.f, 0.f, 0.f, 0.f}; }
    for (int k0 = 0; k0 < DM; k0 += 32) {
        bf16x8 af[2], b1[2], b3[2];
#pragma unroll
        for (int r = 0; r < 2; ++r) { af[r] = *(const bf16x8*)(ap[r] + k0); b1[r] = *(const bf16x8*)(b1p[r] + k0); b3[r] = *(const bf16x8*)(b3p[r] + k0); }
#pragma unroll
        for (int a = 0; a < 2; ++a)
#pragma unroll
            for (int b = 0; b < 2; ++b) { aa[a][b] = __builtin_amdgcn_mfma_f32_16x16x32_bf16(af[a], b1[b], aa[a][b], 0, 0, 0); ab[a][b] = __builtin_amdgcn_mfma_f32_16x16x32_bf16(af[a], b3[b], ab[a][b], 0, 0, 0); }
    }
#pragma unroll
    for (int a = 0; a < 2; ++a)
#pragma unroll
        for (int r = 0; r < 4; ++r) { const int slot = rt * 32 + 16 * a + 4 * g + r; if (slot < n) { const float cw = lw[(size_t)e * LISTCAP + slot];
#pragma unroll
                for (int b = 0; b < 2; ++b) HID[(size_t)(ho + slot) * DEXP + ct * 32 + 16 * b + i] = (bf16)f2bf(siluf(aa[a][b][r]) * ab[a][b][r] * cw); } }
}
__global__ __launch_bounds__(64) void k_moe_dn_naive(const bf16* __restrict__ HID, const bf16* __restrict__ Wdn, const unsigned* __restrict__ cnt, const unsigned* __restrict__ list, bf16* __restrict__ Y2) {
    const int e = blockIdx.z, rt = blockIdx.y, ct = blockIdx.x, lane = threadIdx.x, i = lane & 15, g = lane >> 4;
    const int n = (int)cnt[e]; if (rt * 32 >= n) return;
    const unsigned ho = hid_off(cnt, e);
    const bf16* ap[2]; const bf16* bp[2];
#pragma unroll
    for (int r = 0; r < 2; ++r) { int slot = rt * 32 + 16 * r + i; slot = slot < n ? slot : n - 1; ap[r] = HID + (size_t)(ho + slot) * DEXP + 8 * g; bp[r] = Wdn + ((size_t)e * DM + ct * 32 + 16 * r + i) * DEXP + 8 * g; }
    f32x4 acc[2][2];
#pragma unroll
    for (int a = 0; a < 2; ++a)
#pragma unroll
        for (int b = 0; b < 2; ++b) acc[a][b] = (f32x4){0.f, 0.f, 0.f, 0.f};
    for (int k0 = 0; k0 < DEXP; k0 += 32) {
        bf16x8 af[2], bfr[2];
#pragma unroll
        for (int r = 0; r < 2; ++r) { af[r] = *(const bf16x8*)(ap[r] + k0); bfr[r] = *(const bf16x8*)(bp[r] + k0); }
#pragma unroll
        for (int a = 0; a < 2; ++a)
#pragma unroll
            for (int b = 0; b < 2; ++b) acc[a][b] = __builtin_amdgcn_mfma_f32_16x16x32_bf16(af[a], bfr[b], acc[a][b], 0, 0, 0);
    }
#pragma unroll
    for (int a = 0; a < 2; ++a)
#pragma unroll
        for (int r = 0; r < 4; ++r) { const int slot = rt * 32 + 16 * a + 4 * g + r; if (slot < n) { const unsigned tk = list[(size_t)e * LISTCAP + slot];
#pragma unroll
                for (int b = 0; b < 2; ++b) Y2[((size_t)(tk & 1u) * M + (tk >> 1)) * DM + ct * 32 + 16 * b + i] = (bf16)f2bf(acc[a][b][r]); } }
}
__global__ __launch_bounds__(256) void k_final(const bf16* __restrict__ Y2, const float* __restrict__ g_post, const float* __restrict__ part, const float* __restrict__ b_ada, float* __restrict__ out) {
    const int lane = threadIdx.x & 63, m = blockIdx.x * 4 + (threadIdx.x >> 6), b = m / SEQ;
    f32x4 yv[8]; float ss = 0.f;
#pragma unroll
    for (int j = 0; j < 8; ++j) { const int col = 256 * j + 4 * lane; const u32x2 w0 = *(const u32x2*)(Y2 + (size_t)m * DM + col), w1 = *(const u32x2*)(Y2 + ((size_t)M + m) * DM + col);
        yv[j] = (f32x4){bf2f(w0.x & 0xffffu) + bf2f(w1.x & 0xffffu), bf2f(w0.x >> 16) + bf2f(w1.x >> 16), bf2f(w0.y & 0xffffu) + bf2f(w1.y & 0xffffu), bf2f(w0.y >> 16) + bf2f(w1.y >> 16)};
        ss += yv[j].x * yv[j].x + yv[j].y * yv[j].y + yv[j].z * yv[j].z + yv[j].w * yv[j].w; }
    const float r = rsqrtf(wave_sum(ss) * (1.f / DM) + EPS);
#pragma unroll
    for (int j = 0; j < 8; ++j) { const int col = 256 * j + 4 * lane; const f32x4 gp = *(const f32x4*)(g_post + col), gt = ada_get4(part, b_ada, b, 5 * DM + col);
        f32x4* op = (f32x4*)(out + (size_t)m * DM + col); *op = *op + gt * (yv[j] * r * gp); }
}

extern "C" void kernel_launch(void* const* d_in, const int* in_sizes, int n_in, void* d_out, int out_size, void* d_ws, size_t ws_size, hipStream_t stream) {
    if (n_in != 26 || in_sizes[0] != M * DM || out_size != M * DM || ws_size < WS_END) { fprintf(stderr, "kernel_launch: unexpected shapes (n_in %d, in0 %d, out %d, ws %zu < %zu)\n", n_in, n_in > 0 ? in_sizes[0] : -1, out_size, ws_size, (size_t)WS_END); return; }
    const float* x = (const float*)d_in[0]; const float* c = (const float*)d_in[1]; const float* rel_bias = (const float*)d_in[2]; const float* w_ada = (const float*)d_in[3]; const float* b_ada = (const float*)d_in[4];
    const float* g_pre_mix = (const float*)d_in[5]; const float* g_post_mix = (const float*)d_in[6]; const float* w_in = (const float*)d_in[7]; const float* w_alpha = (const float*)d_in[8]; const float* b_alpha = (const float*)d_in[9];
    const float* lq1 = (const float*)d_in[10]; const float* lk1 = (const float*)d_in[11]; const float* lq2 = (const float*)d_in[12]; const float* lk2 = (const float*)d_in[13];
    const float* g_sub_a = (const float*)d_in[14]; const float* g_norm_b = (const float*)d_in[15]; const float* w_out = (const float*)d_in[16]; const float* g_pre_ffn = (const float*)d_in[17]; const float* g_post_ffn = (const float*)d_in[18];
    const float* w_rg = (const float*)d_in[19]; const float* b_rg = (const float*)d_in[20]; const float* w_re = (const float*)d_in[21]; const float* b_re = (const float*)d_in[22];
    const float* w1 = (const float*)d_in[23]; const float* w3 = (const float*)d_in[24]; const float* w2 = (const float*)d_in[25];
    char* ws = (char*)d_ws; float* out = (float*)d_out;
    unsigned* cnt = (unsigned*)(ws + WS_CTL); float* adap = (float*)(ws + WS_ADAP); float* ZB = (float*)(ws + WS_ZB); unsigned* list = (unsigned*)(ws + WS_LIST); float* lw = (float*)(ws + WS_LW);
    bf16* Win = (bf16*)(ws + WS_WIN); bf16* Wout = (bf16*)(ws + WS_WOUT); bf16* Wup = (bf16*)(ws + WS_WUP); bf16* Wdn = (bf16*)(ws + WS_WDN);
    bf16* H = (bf16*)(ws + WS_H); bf16* CAT = (bf16*)(ws + WS_CAT); bf16* PROJ = (bf16*)(ws + WS_PROJ); bf16* Y = (bf16*)(ws + WS_Y); bf16* H2 = (bf16*)(ws + WS_H2); bf16* Y2 = (bf16*)(ws + WS_Y2); bf16* HID = (bf16*)(ws + WS_HID);
    hipMemsetAsync(ws + WS_CTL, 0, 1 * MiB, stream);
    hipLaunchKernelGGL(k_ada, dim3(NADA / 256, 4), dim3(256), 0, stream, c, w_ada, adap);
    hipLaunchKernelGGL(k_transpose, dim3(NPROJ / 32, DM / 32, 1), dim3(256), 0, stream, w_in, DM, D_IN, (size_t)0, Win, 128, 0, (size_t)0);
    hipLaunchKernelGGL(k_transpose, dim3(DM / 32, DM / 32, 1), dim3(256), 0, stream, w_out, DM, DM, (size_t)0, Wout, 128, 0, (size_t)0);
    hipLaunchKernelGGL(k_transpose, dim3(DEXP / 32, DM / 32, NEXP), dim3(256), 0, stream, w1, DM, DEXP, (size_t)DM * DEXP, Wup, 256, 0, (size_t)1024 * DM);
    hipLaunchKernelGGL(k_transpose, dim3(DEXP / 32, DM / 32, NEXP), dim3(256), 0, stream, w3, DM, DEXP, (size_t)DM * DEXP, Wup, 256, 128, (size_t)1024 * DM);
    hipLaunchKernelGGL(k_transpose, dim3(DM / 32, DEXP / 32, NEXP), dim3(256), 0, stream, w2, DEXP, DM, (size_t)DM * DEXP, Wdn, 128, 0, (size_t)DM * DEXP);
    hipLaunchKernelGGL(k_prenorm, dim3(M / 4), dim3(256), 0, stream, x, g_pre_mix, adap, b_ada, w_in, H, ZB);
    hipLaunchKernelGGL(k_gemm_naive<1>, dim3((M / 32) * (NPROJ / 32) / 4), dim3(256), 0, stream, H, Win, M, NPROJ, DM, PROJ, NPROJ);
    hipLaunchKernelGGL(k_attn_naive, dim3(BATCH * 8 * 64), dim3(64), 0, stream, PROJ, rel_bias, lq1, lk1, lq2, lk2, g_sub_a, CAT);
    hipLaunchKernelGGL(k_gla_naive, dim3(BATCH * 4), dim3(256), 0, stream, PROJ, ZB, w_alpha, b_alpha, g_norm_b, CAT);
    hipLaunchKernelGGL(k_gemm_naive<0>, dim3((M / 32) * (DM / 32) / 4), dim3(256), 0, stream, CAT, Wout, M, DM, DM, Y, DM);
    hipLaunchKernelGGL(k_mid, dim3(M / 4), dim3(256), 0, stream, x, Y, g_post_mix, g_pre_ffn, adap, b_ada, w_rg, b_rg, w_re, b_re, out, H2, cnt, list, lw);
    hipLaunchKernelGGL(k_moe_up_naive, dim3(DEXP / 32, LISTCAP / 32, NEXP), dim3(64), 0, stream, H2, Wup, cnt, list, lw, HID);
    hipLaunchKernelGGL(k_moe_dn_naive, dim3(DM / 32, LISTCAP / 32, NEXP), dim3(64), 0, stream, HID, Wdn, cnt, list, Y2);
    hipLaunchKernelGGL(k_final, dim3(M / 4), dim3(256), 0, stream, Y2, g_post_ffn, adap, b_ada, out);
}
```

```cpp
#include <hip/hip_runtime.h>
#include <cstdio>
#include <cstdint>
typedef unsigned u32x2 __attribute__((ext_vector_type(2)));
constexpr int BATCH = 4, SEQ = 4096, DM = 2048, M = BATCH * SEQ;
constexpr int D_IN = 6160, NPROJ = 6144;
constexpr int NADA = 6 * DM;
constexpr int NEXP = 32, DEXP = 512, LISTCAP = M;
constexpr float EPS = 1e-6f;
constexpr float LOG2E = 1.4426950408889634f;
constexpr float QA_SCALE = 0.125f * LOG2E;
constexpr float QB_SCALE = 0.08838834764831845f;
constexpr float LAM_INIT = 0.2f;
constexpr int C_QA = 0, C_KA = 1024, C_VA = 2048, C_QB = 3072, C_KB = 3584, C_VB = 4096, C_RB = 5120;

constexpr size_t MiB = 1u << 20;
constexpr size_t WS_CTL = 0;
constexpr size_t WS_ADAP = 1 * MiB;
constexpr size_t WS_FRAGR = 1 * MiB + 768 * 1024;
constexpr size_t WS_FRAGZ = WS_FRAGR + 192 * 1024;
constexpr size_t WS_ZB = 2 * MiB;
constexpr size_t WS_LIST = 3 * MiB;
constexpr size_t WS_LW = 5 * MiB;
constexpr size_t WS_RS = 7 * MiB;
constexpr int CW_CMAX = 131072;
constexpr size_t WS_WIN = 8 * MiB;
constexpr size_t WS_WOUT = 32 * MiB;
constexpr size_t WS_WUP = 40 * MiB;
constexpr size_t WS_WDN = 168 * MiB;
constexpr size_t WS_H = 232 * MiB;
constexpr size_t WS_CAT = 296 * MiB;
constexpr size_t WS_PROJ = 360 * MiB;
constexpr size_t WS_Y2 = WS_PROJ;
constexpr size_t WS_HID = WS_PROJ + 128 * MiB;
constexpr size_t WS_GLA = 552 * MiB;
constexpr size_t WS_END = 568 * MiB;
constexpr size_t WS_Y = WS_H, WS_H2 = WS_CAT;
constexpr int HID_ROWS = 41216;

__device__ __forceinline__ int lane_id() { unsigned ones = ~0u; asm volatile("" : "+s"(ones)); return (int)__builtin_amdgcn_mbcnt_hi(ones, __builtin_amdgcn_mbcnt_lo(ones, 0u)); }
template <int S> __device__ __forceinline__ float swz_xor(float v) { return __int_as_float(__builtin_amdgcn_ds_swizzle(__float_as_int(v), (S << 10) | 0x1f)); }
__device__ __forceinline__ float half_sum(float v) { v += swz_xor<1>(v); v += swz_xor<2>(v); v += swz_xor<4>(v); v += swz_xor<8>(v); v += swz_xor<16>(v); return v; }
__device__ __forceinline__ float wave_sum(float v) { v = half_sum(v); auto rr = __builtin_amdgcn_permlane32_swap(__float_as_uint(v), __float_as_uint(v), false, false); return __uint_as_float(rr[0]) + __uint_as_float(rr[1]); }
typedef float cf32x2_t __attribute__((ext_vector_type(2))); typedef __bf16 cbf16x2_t __attribute__((ext_vector_type(2)));
__device__ __forceinline__ unsigned cvt2bf(float lo, float hi) { cf32x2_t v = {lo, hi}; cbf16x2_t b = __builtin_convertvector(v, cbf16x2_t); return __builtin_bit_cast(unsigned, b); }
__device__ __forceinline__ unsigned pk4_fp8(float a, float b, float cc, float d) { int w = __builtin_amdgcn_cvt_pk_fp8_f32(a, b, 0, false); w = __builtin_amdgcn_cvt_pk_fp8_f32(cc, d, w, true); return (unsigned)w; }
constexpr float F8_WSCALE = 32.f, F8_ASCALE = 8.f;
__device__ __forceinline__ float wave_max(float v) { v = fmaxf(v, swz_xor<1>(v)); v = fmaxf(v, swz_xor<2>(v)); v = fmaxf(v, swz_xor<4>(v)); v = fmaxf(v, swz_xor<8>(v)); v = fmaxf(v, swz_xor<16>(v));
    auto rr = __builtin_amdgcn_permlane32_swap(__float_as_uint(v), __float_as_uint(v), false, false); return fmaxf(__uint_as_float(rr[0]), __uint_as_float(rr[1])); }
__device__ __forceinline__ unsigned pk4_i8(float a, float b, float cc, float d, float qs) {
    const unsigned t0 = __float_as_uint(fmaf(a, qs, 12582912.f)), t1 = __float_as_uint(fmaf(b, qs, 12582912.f)), t2 = __float_as_uint(fmaf(cc, qs, 12582912.f)), t3 = __float_as_uint(fmaf(d, qs, 12582912.f));
    return __builtin_amdgcn_perm(__builtin_amdgcn_perm(t3, t2, 0x0c0c0400u), __builtin_amdgcn_perm(t1, t0, 0x0c0c0400u), 0x05040100u); }
namespace pg8 {
#define PG8_LAS __attribute__((address_space(3)))
typedef unsigned short bf16_t;
typedef short bf16x8 __attribute__((ext_vector_type(8)));
typedef float f32x4 __attribute__((ext_vector_type(4)));
typedef unsigned u32x4 __attribute__((ext_vector_type(4)));
typedef unsigned u32x2 __attribute__((ext_vector_type(2)));
constexpr int BM = 256, BK = 64, HALF = 128, HTB = HALF * BK * 2  , STAGE_BYTES = 8 * HTB, NXCD = 8, WGM = 8;

__host__ __device__ __forceinline__ int lds_byte(int r, int c) { const int st = (r >> 4) * 2 + (c >> 5), rr = r & 15, cc = c & 31, ob = rr * 64 + cc * 2; return st * 1024 + (ob ^ (((ob >> 9) & 1) << 5)); }
__host__ __device__ __forceinline__ void stage_rc(int b, int& R, int& C) { const int st = b / 1024, sb = b % 1024, swz = sb ^ (((sb >> 9) & 1) << 5); R = (st >> 1) * 16 + swz / 64; C = (st & 1) * 32 + (swz % 64) / 2; }
__host__ __device__ __forceinline__ int perm32(int rho) { const int n = rho >> 4, i = rho & 15; return 8 * (i >> 2) + 4 * n + (i & 3); }

struct Unit { int pm, pn, ui, e; };
struct Gemm { const bf16_t* A; const bf16_t* Bt; int M, N, K; };

struct StaticOrder {
    int nM, nN, nwg, G, c;
    __host__ __device__ void init(int M, int N, int G_, int c_) { nM = M / BM; nN = N / BM; nwg = nM * nN; G = G_; c = c_; }
    __host__ __device__ bool next(int i, Unit& u) const {
        const long L = (long)i * G + c; if (L >= nwg) return false;
        int wgid = (int)L; { const int q = nwg / NXCD, r = nwg % NXCD, xcd = wgid % NXCD, off = wgid / NXCD; wgid = (xcd < r ? xcd * (q + 1) : r * (q + 1) + (xcd - r) * q) + off; }
        const int nig = WGM * nN, gid = wgid / nig, fm = gid * WGM, gsz = (nM - fm) < WGM ? (nM - fm) : WGM;
        u.pm = fm + ((wgid % nig) % gsz); u.pn = (wgid % nig) / gsz; return true;
    }
    __device__ __forceinline__ void a_ready(const Unit&) const {}
    __device__ __forceinline__ void done(const Unit&) const {}
};

__device__ __forceinline__ unsigned cvt_pk_bf16(float lo, float hi) { unsigned r; asm volatile("v_cvt_pk_bf16_f32 %0, %1, %2" : "=v"(r) : "v"(lo), "v"(hi)); return r; }
typedef float f32x2 __attribute__((ext_vector_type(2)));
struct EpiProj {
    static constexpr bool PERM = true, AFTER_DRAIN = false;
    bf16_t* O; int ldc;
    __device__ __forceinline__ void operator()(const f32x4 (&acc)[2][2][4][2], const Unit& u, int wr, int wc, int fr, int fq) const {
        const int row0 = u.pm * BM + wr * 64 + fr, col0 = u.pn * BM + wc * 32 + 8 * fq;
        const float sc = (u.pn < 4) ? QA_SCALE : ((u.pn == 12 || u.pn == 13) ? QB_SCALE : 1.f);
#pragma unroll
        for (int ai = 0; ai < 2; ++ai)
#pragma unroll
            for (int m = 0; m < 4; ++m) { bf16_t* rowp = O + (size_t)(row0 + ai * HALF + m * 16) * ldc + col0;
#pragma unroll
                for (int bj = 0; bj < 2; ++bj) { const f32x4 v0 = acc[ai][bj][m][0] * sc, v1 = acc[ai][bj][m][1] * sc;
                    u32x4 w; w.x = cvt_pk_bf16(v0[0], v0[1]); w.y = cvt_pk_bf16(v0[2], v0[3]); w.z = cvt_pk_bf16(v1[0], v1[1]); w.w = cvt_pk_bf16(v1[2], v1[3]);
                    *(u32x4*)(rowp + bj * HALF) = w; } }
    }
};
struct EpiPlain {
    static constexpr bool PERM = true, AFTER_DRAIN = false; static constexpr int NST = 0;
    bf16_t* O; int ldc;
    __device__ __forceinline__ void operator()(const f32x4 (&acc)[2][2][4][2], const Unit& u, int wr, int wc, int fr, int fq) const {
        const int row0 = u.pm * BM + wr * 64 + fr, col0 = u.pn * BM + wc * 32 + 8 * fq;
#pragma unroll
        for (int ai = 0; ai < 2; ++ai)
#pragma unroll
            for (int m = 0; m < 4; ++m) { bf16_t* rowp = O + (size_t)(row0 + ai * HALF + m * 16) * ldc + col0;
#pragma unroll
                for (int bj = 0; bj < 2; ++bj) { const f32x4 v0 = acc[ai][bj][m][0], v1 = acc[ai][bj][m][1];
                    u32x4 w; w.x = cvt_pk_bf16(v0[0], v0[1]); w.y = cvt_pk_bf16(v0[2], v0[3]); w.z = cvt_pk_bf16(v1[0], v1[1]); w.w = cvt_pk_bf16(v1[2], v1[3]);
                    *(u32x4*)(rowp + bj * HALF) = w; } }
    }
};
template <class Epi, class Sched, bool ALIGN_EPI = false, bool SP2 = false>
__device__ __forceinline__ void gemm_phase(PG8_LAS unsigned char* lds, const Gemm g, const Sched& S, const Epi& E, int wave_id) {
    const int wid = wave_id, lane = lane_id(), tid = wid * 64 + lane, wr = wid >> 2, wc = wid & 3, fr = lane & 15, fq = lane >> 4;
    const int K = g.K, nt = K / BK;
    unsigned voffA[2], voffB[2];
#pragma unroll
    for (int i = 0; i < 2; ++i) { int R, C; stage_rc(tid * 16 + i * 8192, R, C); const int Rb = Epi::PERM ? ((R & ~31) + perm32(R & 31)) : R;
        voffA[i] = (unsigned)(R * K + C) * 2u; voffB[i] = (unsigned)(Rb * K + C) * 2u; }
    const size_t kstep = (size_t)(BK * 2);
    const size_t hstep = (size_t)HALF * K * 2;
    const size_t tstep = 2 * hstep;
    const unsigned ldsw = (unsigned)wid * 1024u;
    const int aoff = lds_byte(wr * 64 + fr, fq * 8), boff = lds_byte(wc * 32 + fr, fq * 8);
#define PG8_SA(b, h) (((b) * 2 + (h)) * HTB)
#define PG8_SB(b, h) ((4 + (b) * 2 + (h)) * HTB)
#define PG8_STAGE(bufoff, gbase, voff) do { _Pragma("unroll") for (int _i = 0; _i < 2; ++_i) \
        __builtin_amdgcn_global_load_lds((const unsigned*)((const char*)(gbase) + (voff)[_i]), (PG8_LAS unsigned*)(lds + (bufoff) + ldsw + _i * 8192), 16, 0, 0); } while (0)
#define PG8_LDA(dst, b, h) do { _Pragma("unroll") for (int m = 0; m < 4; ++m) _Pragma("unroll") for (int k = 0; k < 2; ++k) dst[m][k] = *(const PG8_LAS bf16x8*)(lds + PG8_SA(b, h) + aoff + m * 2048 + k * 1024); } while (0)
#define PG8_LDB(dst, b, h) do { _Pragma("unroll") for (int n = 0; n < 2; ++n) _Pragma("unroll") for (int k = 0; k < 2; ++k) dst[n][k] = *(const PG8_LAS bf16x8*)(lds + PG8_SB(b, h) + boff + n * 2048 + k * 1024); } while (0)
#define PG8_MMA(ai, bj, At, Bt) do { __builtin_amdgcn_s_setprio(1); _Pragma("unroll") for (int m = 0; m < 4; ++m) _Pragma("unroll") for (int n = 0; n < 2; ++n) _Pragma("unroll") for (int k = 0; k < 2; ++k) \
        acc[ai][bj][m][n] = __builtin_amdgcn_mfma_f32_16x16x32_bf16(Bt[n][k], At[m][k], acc[ai][bj][m][n], 0, 0, 0); __builtin_amdgcn_s_setprio(0); } while (0)
#define PG8_WAIT_V(n) asm volatile("s_waitcnt vmcnt(" #n ")" ::: "memory")
#define PG8_WAIT_L(n) asm volatile("s_waitcnt lgkmcnt(" #n ")" ::: "memory")
#define PG8_BAR __builtin_amdgcn_s_barrier()
#define PG8_SCHED __builtin_amdgcn_sched_barrier(0)
    Unit cur, nxt; int ui = 0;
    if (!S.next(0, cur)) return;
    f32x4 acc[2][2][4][2];
#pragma unroll
    for (int a = 0; a < 2; ++a)
#pragma unroll
        for (int b = 0; b < 2; ++b)
#pragma unroll
            for (int m = 0; m < 4; ++m)
#pragma unroll
                for (int n = 0; n < 2; ++n) acc[a][b][m][n] = (f32x4){0.f, 0.f, 0.f, 0.f};
    bf16x8 At[4][2], B0[2][2], B1[2][2];
    const char* cA = (const char*)g.A + (size_t)cur.pm * tstep; const char* cB = (const char*)g.Bt + (size_t)cur.pn * tstep;
    S.a_ready(cur);
    if constexpr (SP2) {
        PG8_STAGE(PG8_SB(0, 0), cB, voffB); PG8_STAGE(PG8_SB(0, 1), cB + hstep, voffB); PG8_STAGE(PG8_SA(0, 0), cA, voffA); PG8_STAGE(PG8_SA(0, 1), cA + hstep, voffA);
        if (wr == 1) PG8_BAR;
        PG8_WAIT_V(2); PG8_BAR;
        PG8_STAGE(PG8_SB(1, 0), cB + kstep, voffB); PG8_STAGE(PG8_SA(1, 0), cA + kstep, voffA); PG8_STAGE(PG8_SB(1, 1), cB + hstep + kstep, voffB);
        PG8_WAIT_V(6); PG8_BAR;
    } else {
        PG8_STAGE(PG8_SB(0, 0), cB, voffB); PG8_STAGE(PG8_SA(0, 0), cA, voffA); PG8_STAGE(PG8_SB(0, 1), cB + hstep, voffB); PG8_STAGE(PG8_SA(0, 1), cA + hstep, voffA);
        if (wr == 1) PG8_BAR;
        PG8_WAIT_V(4); PG8_BAR;
        PG8_STAGE(PG8_SB(1, 0), cB + kstep, voffB); PG8_STAGE(PG8_SA(1, 0), cA + kstep, voffA); PG8_STAGE(PG8_SB(1, 1), cB + hstep + kstep, voffB);
        PG8_WAIT_V(6); PG8_BAR;
    }
    for (;;) {
        const bool has_next = S.next(ui + 1, nxt);
        const char* nA = has_next ? (const char*)g.A + (size_t)nxt.pm * tstep : cA; const char* nB = has_next ? (const char*)g.Bt + (size_t)nxt.pn * tstep : cB;
        for (int t = 0; t < nt; t += 2) {
            const bool last = (t == nt - 2);
            const char* a1 = cA + (size_t)(t + 1) * kstep;
            const char* a2 = last ? nA : cA + (size_t)(t + 2) * kstep; const char* b2 = last ? nB : cB + (size_t)(t + 2) * kstep;
            const char* a3 = a2 + kstep; const char* b3 = b2 + kstep;
            if (last && has_next) S.a_ready(nxt);
            if constexpr (SP2) {
            PG8_LDB(B0, 0, 0); PG8_LDB(B1, 0, 1); PG8_SCHED; PG8_LDA(At, 0, 0); PG8_STAGE(PG8_SA(1, 1), a1 + hstep, voffA);
            PG8_WAIT_V(8); PG8_WAIT_L(0); PG8_BAR; PG8_MMA(0, 0, At, B0); PG8_MMA(0, 1, At, B1); PG8_BAR; PG8_SCHED;
            PG8_LDA(At, 0, 1); PG8_STAGE(PG8_SB(0, 0), b2, voffB); PG8_STAGE(PG8_SB(0, 1), b2 + hstep, voffB); PG8_STAGE(PG8_SA(0, 0), a2, voffA);
            PG8_WAIT_V(8); PG8_WAIT_L(0); PG8_BAR; PG8_MMA(1, 0, At, B0); PG8_MMA(1, 1, At, B1); PG8_BAR; PG8_SCHED;
            PG8_LDB(B0, 1, 0); PG8_LDB(B1, 1, 1); PG8_SCHED; PG8_LDA(At, 1, 0); PG8_STAGE(PG8_SA(0, 1), a2 + hstep, voffA);
            PG8_WAIT_V(8); PG8_WAIT_L(0); PG8_BAR; PG8_MMA(0, 0, At, B0); PG8_MMA(0, 1, At, B1); PG8_BAR; PG8_SCHED;
            PG8_LDA(At, 1, 1); PG8_STAGE(PG8_SB(1, 0), b3, voffB); PG8_STAGE(PG8_SB(1, 1), b3 + hstep, voffB); PG8_STAGE(PG8_SA(1, 0), a3, voffA);
            PG8_WAIT_V(8); PG8_WAIT_L(0); PG8_BAR; PG8_MMA(1, 0, At, B0); PG8_MMA(1, 1, At, B1); PG8_BAR; PG8_SCHED;
            } else {
            PG8_LDB(B0, 0, 0); PG8_SCHED; PG8_LDA(At, 0, 0); PG8_STAGE(PG8_SA(1, 1), a1 + hstep, voffA);
            PG8_WAIT_L(8); PG8_BAR; PG8_WAIT_L(0); PG8_MMA(0, 0, At, B0); PG8_BAR; PG8_SCHED;
            PG8_LDB(B1, 0, 1); PG8_STAGE(PG8_SB(0, 0), b2, voffB);
            PG8_BAR; PG8_WAIT_L(0); PG8_MMA(0, 1, At, B1); PG8_BAR;
            PG8_LDA(At, 0, 1); PG8_STAGE(PG8_SA(0, 0), a2, voffA);
            PG8_BAR; PG8_WAIT_L(0); PG8_MMA(1, 0, At, B0); PG8_BAR; PG8_SCHED;
            PG8_STAGE(PG8_SB(0, 1), b2 + hstep, voffB);
            PG8_WAIT_V(6); PG8_BAR; PG8_MMA(1, 1, At, B1); PG8_BAR;
            PG8_LDB(B0, 1, 0); PG8_SCHED; PG8_LDA(At, 1, 0); PG8_STAGE(PG8_SA(0, 1), a2 + hstep, voffA);
            PG8_WAIT_L(8); PG8_BAR; PG8_WAIT_L(0); PG8_MMA(0, 0, At, B0); PG8_BAR; PG8_SCHED;
            PG8_LDB(B1, 1, 1); PG8_STAGE(PG8_SB(1, 0), b3, voffB);
            PG8_BAR; PG8_WAIT_L(0); PG8_MMA(0, 1, At, B1); PG8_BAR;
            PG8_LDA(At, 1, 1); PG8_STAGE(PG8_SA(1, 0), a3, voffA);
            PG8_BAR; PG8_WAIT_L(0); PG8_MMA(1, 0, At, B0); PG8_BAR; PG8_SCHED;
            PG8_STAGE(PG8_SB(1, 1), b3 + hstep, voffB);
            PG8_WAIT_V(6); PG8_BAR; PG8_MMA(1, 1, At, B1); PG8_BAR;
            }
        }
        if constexpr (ALIGN_EPI) { if (wr == 0) PG8_BAR; }
        if constexpr (!Epi::AFTER_DRAIN) { E(acc, cur, wr, wc, fr, fq); S.done(cur); }
        if (!has_next) break;
#pragma unroll
        for (int a = 0; a < 2; ++a)
#pragma unroll
            for (int b = 0; b < 2; ++b)
#pragma unroll
                for (int m = 0; m < 4; ++m)
#pragma unroll
                    for (int n = 0; n < 2; ++n) acc[a][b][m][n] = (f32x4){0.f, 0.f, 0.f, 0.f};
        cur = nxt; cA = nA; cB = nB; ++ui;
        if constexpr (ALIGN_EPI) { if (wr == 1) PG8_BAR; }
    }
    PG8_WAIT_V(0);
    if constexpr (!ALIGN_EPI) { if (wr == 0) PG8_BAR; }
    PG8_BAR;
    if constexpr (Epi::AFTER_DRAIN) { E.fused(acc, cur, wr, wc, fr, fq, lds, wid, lane); S.done(cur); }
#undef PG8_SA
#undef PG8_SB
#undef PG8_STAGE
#undef PG8_LDA
#undef PG8_LDB
#undef PG8_MMA
#undef PG8_WAIT_V
#undef PG8_WAIT_L
#undef PG8_BAR
#undef PG8_SCHED
}

__device__ __forceinline__ void glds16s(const void* sbase, unsigned voff, unsigned lds_dst) {
    asm volatile("s_mov_b32 m0, %2\n\ts_nop 0\n\tglobal_load_lds_dwordx4 %0, %1" :: "v"(voff), "s"(sbase), "s"(lds_dst) : "memory"); }
template <class Epi, class Sched, int MODE = 0>
__device__ __forceinline__ void gemm_phase_g(PG8_LAS unsigned char* lds, const Gemm g, const Sched& S, const Epi& E, int wave_id) {
    constexpr bool F8 = (MODE == 1);
    const int wid = wave_id, lane = lane_id(), tid = wid * 64 + lane, wr = wid >> 2, wc = wid & 3, fr = lane & 15, fq = lane >> 4;
    const int K = g.K, nt = K / BK;
    unsigned voffB[2];
#pragma unroll
    for (int i = 0; i < 2; ++i) { int R, C; stage_rc(tid * 16 + i * 8192, R, C); const int Rb = Epi::PERM ? ((R & ~31) + perm32(R & 31)) : R; voffB[i] = (unsigned)(Rb * K + C) * 2u; }
#define PG8_AOFFS(u, dst) do { int Rr_[2], Cc_[2]; const int t_ = wid * 64 + lane_id(); _Pragma("unroll") for (int i = 0; i < 2; ++i) stage_rc(t_ * 16 + i * 8192, Rr_[i], Cc_[i]); S.a_offs(g, u, Rr_, Cc_, dst); } while (0)
    const size_t kstep = (size_t)(BK * 2);
    const size_t hstep = (size_t)HALF * K * 2;
    const unsigned ldsu = (unsigned)__builtin_amdgcn_readfirstlane((int)((unsigned)(uintptr_t)lds + (unsigned)wid * 1024u));
    const int aoff = lds_byte(wr * 64 + fr, fq * (F8 ? 16 : 8)), boff = lds_byte(wc * 32 + fr, fq * (F8 ? 16 : 8));
    constexpr int KOFF = F8 ? 16 : 1024;
    int abase8 = (int)(unsigned)(uintptr_t)lds + aoff, bbase8 = (int)(unsigned)(uintptr_t)lds + 65536 + boff;
    asm volatile("" : "+v"(abase8), "+v"(bbase8));
#define PG8_SA(b, h) (((b) * 2 + (h)) * HTB)
#define PG8_SB(b, h) ((4 + (b) * 2 + (h)) * HTB)
#define PG8_STAGE(bufoff, gbase, voff) do { _Pragma("unroll") for (int _i = 0; _i < 2; ++_i) \
        glds16s((const void*)(gbase), (voff)[_i], ldsu + (unsigned)((bufoff) + _i * 8192)); } while (0)
#define PG8_LDA(dst, b, h) do { if constexpr (F8) { _Pragma("unroll") for (int m = 0; m < 4; ++m) dst##8[m] = *(const PG8_LAS v8i_t*)(unsigned)(abase8 + PG8_SA(b, h) + m * 2048); } \
        else { _Pragma("unroll") for (int m = 0; m < 4; ++m) _Pragma("unroll") for (int k = 0; k < 2; ++k) dst[m][k] = *(const PG8_LAS bf16x8*)(lds + PG8_SA(b, h) + aoff + m * 2048 + k * KOFF); } } while (0)
#define PG8_LDB(dst, b, h) do { if constexpr (F8) { _Pragma("unroll") for (int n = 0; n < 2; ++n) dst##8[n] = *(const PG8_LAS v8i_t*)(unsigned)(bbase8 + (PG8_SB(b, h) - 65536) + n * 2048); } \
        else { _Pragma("unroll") for (int n = 0; n < 2; ++n) _Pragma("unroll") for (int k = 0; k < 2; ++k) dst[n][k] = *(const PG8_LAS bf16x8*)(lds + PG8_SB(b, h) + boff + n * 2048 + k * KOFF); } } while (0)
#define PG8_MMA(ai, bj, At, Bt) do { __builtin_amdgcn_s_setprio(1); \
        if constexpr (F8) { _Pragma("unroll") for (int m = 0; m < 4; ++m) _Pragma("unroll") for (int n = 0; n < 2; ++n) \
            acc[ai][bj][m][n] = __builtin_amdgcn_mfma_scale_f32_16x16x128_f8f6f4(Bt##8[n], At##8[m], acc[ai][bj][m][n], 0, 0, 0, 0x7f7f7f7f, 0, 0x7f7f7f7f); } \
        else if constexpr (MODE == 2) { _Pragma("unroll") for (int m = 0; m < 4; ++m) _Pragma("unroll") for (int n = 0; n < 2; ++n) _Pragma("unroll") for (int k = 0; k < 2; ++k) \
            acc[ai][bj][m][n] = __builtin_bit_cast(f32x4, __builtin_amdgcn_mfma_i32_16x16x64_i8(__builtin_bit_cast(v4i_t, Bt[n][k]), __builtin_bit_cast(v4i_t, At[m][k]), __builtin_bit_cast(v4i_t, acc[ai][bj][m][n]), 0, 0, 0)); } \
        else { _Pragma("unroll") for (int m = 0; m < 4; ++m) _Pragma("unroll") for (int n = 0; n < 2; ++n) _Pragma("unroll") for (int k = 0; k < 2; ++k) \
            acc[ai][bj][m][n] = __builtin_amdgcn_mfma_f32_16x16x32_bf16(Bt[n][k], At[m][k], acc[ai][bj][m][n], 0, 0, 0); } \
        __builtin_amdgcn_s_setprio(0); } while (0)
#define PG8_WAIT_V(n) asm volatile("s_waitcnt vmcnt(" #n ")" ::: "memory")
#define PG8_WAIT_L(n) asm volatile("s_waitcnt lgkmcnt(" #n ")" ::: "memory")
#define PG8_BAR __builtin_amdgcn_s_barrier()
#define PG8_SCHED __builtin_amdgcn_sched_barrier(0)
    Unit cur, nxt; int ui = 0;
    if (!S.next(0, cur)) return;
    f32x4 acc[2][2][4][2];
#pragma unroll
    for (int a = 0; a < 2; ++a)
#pragma unroll
        for (int b = 0; b < 2; ++b)
#pragma unroll
            for (int m = 0; m < 4; ++m)
#pragma unroll
                for (int n = 0; n < 2; ++n) acc[a][b][m][n] = (f32x4){0.f, 0.f, 0.f, 0.f};
    typedef int v8i_t __attribute__((ext_vector_type(8))); typedef int v4i_t __attribute__((ext_vector_type(4)));
    bf16x8 At[4][2], B0[2][2], B1[2][2];
    v8i_t At8[4], B08[2], B18[2];
    unsigned va[2][2];
    PG8_AOFFS(cur, va);
    const char* const Ab = (const char*)g.A; const char* cB = S.b_base(g, cur);
    PG8_STAGE(PG8_SB(0, 0), cB, voffB); PG8_STAGE(PG8_SB(0, 1), cB + hstep, voffB); PG8_STAGE(PG8_SA(0, 0), Ab, va[0]); PG8_STAGE(PG8_SA(0, 1), Ab, va[1]);
    if (wr == 1) PG8_BAR;
    PG8_WAIT_V(2); PG8_BAR;
    PG8_STAGE(PG8_SB(1, 0), cB + kstep, voffB); PG8_STAGE(PG8_SA(1, 0), Ab + kstep, va[0]); PG8_STAGE(PG8_SB(1, 1), cB + hstep + kstep, voffB);
    PG8_WAIT_V(6); PG8_BAR;
    for (;;) {
        const bool has_next = S.next(ui + 1, nxt);
        const char* nB = cB;
        if (has_next) nB = S.b_base(g, nxt);
#pragma unroll 1
        for (int t = 0; t < nt; t += 2) {
            const bool last = (t == nt - 2);
            const char* a1 = Ab + (size_t)(t + 1) * kstep;
            const size_t k2 = last ? (size_t)0 : (size_t)(t + 2) * kstep;
            const char* a2 = Ab + k2; const char* b2 = (last ? nB : cB) + k2;
            const char* a3 = a2 + kstep; const char* b3 = b2 + kstep;
            const bool fresh = (t == 0) && (ui > 0);
            PG8_LDB(B0, 0, 0); PG8_LDB(B1, 0, 1); PG8_SCHED; PG8_LDA(At, 0, 0); PG8_STAGE(PG8_SA(1, 1), a1, va[1]);
            if (last && has_next) PG8_AOFFS(nxt, va);
            if (fresh) asm volatile("s_waitcnt vmcnt(%0)" :: "n"(8 + Epi::NST) : "memory"); else PG8_WAIT_V(8);
            PG8_WAIT_L(0); PG8_BAR; PG8_MMA(0, 0, At, B0); PG8_MMA(0, 1, At, B1); PG8_BAR; PG8_SCHED;
            PG8_LDA(At, 0, 1); PG8_STAGE(PG8_SB(0, 0), b2, voffB); PG8_STAGE(PG8_SB(0, 1), b2 + hstep, voffB); PG8_STAGE(PG8_SA(0, 0), a2, va[0]);
            if (fresh) asm volatile("s_waitcnt vmcnt(%0)" :: "n"(8 + Epi::NST) : "memory"); else PG8_WAIT_V(8);
            PG8_WAIT_L(0); PG8_BAR; PG8_MMA(1, 0, At, B0); PG8_MMA(1, 1, At, B1); PG8_BAR; PG8_SCHED;
            PG8_LDB(B0, 1, 0); PG8_LDB(B1, 1, 1); PG8_SCHED; PG8_LDA(At, 1, 0); PG8_STAGE(PG8_SA(0, 1), a2, va[1]);
            PG8_WAIT_V(8); PG8_WAIT_L(0); PG8_BAR; PG8_MMA(0, 0, At, B0); PG8_MMA(0, 1, At, B1); PG8_BAR; PG8_SCHED;
            PG8_LDA(At, 1, 1); PG8_STAGE(PG8_SB(1, 0), b3, voffB); PG8_STAGE(PG8_SB(1, 1), b3 + hstep, voffB); PG8_STAGE(PG8_SA(1, 0), a3, va[0]);
            PG8_WAIT_V(8); PG8_WAIT_L(0); PG8_BAR; PG8_MMA(1, 0, At, B0); PG8_MMA(1, 1, At, B1); PG8_BAR; PG8_SCHED;
        }
        if (wr == 0) PG8_BAR;
        E(acc, cur, wr, wc, fr, fq);
        if (!has_next) break;
#pragma unroll
        for (int a = 0; a < 2; ++a)
#pragma unroll
            for (int b = 0; b < 2; ++b)
#pragma unroll
                for (int m = 0; m < 4; ++m)
#pragma unroll
                    for (int n = 0; n < 2; ++n) acc[a][b][m][n] = (f32x4){0.f, 0.f, 0.f, 0.f};
        cur = nxt; cB = nB; ++ui;
        if (wr == 1) PG8_BAR;
    }
    PG8_WAIT_V(0);
    PG8_BAR;
#undef PG8_SA
#undef PG8_SB
#undef PG8_STAGE
#undef PG8_LDA
#undef PG8_LDB
#undef PG8_MMA
#undef PG8_WAIT_V
#undef PG8_WAIT_L
#undef PG8_BAR
#undef PG8_SCHED
#undef PG8_AOFFS
}

constexpr int MOE_MAXU = 6;
__device__ __forceinline__ bool moe_unit(const PG8_LAS unsigned* tstart, int NJ, int G, int c, int i, int& tt, int& pn, int& e) {
    if (i >= MOE_MAXU) return false;
    if (tstart[33] != 0u) { const int x = c & 7, s = c >> 3, t0 = (int)tstart[4 * x], t1 = (int)tstart[4 * x + 4], q = i * (G >> 3) + s; if (q >= (t1 - t0) * NJ) return false; tt = t0 + q / NJ; pn = q % NJ; }
    else { const int L = i * G + c; if (L >= (int)tstart[32] * NJ) return false; tt = L / NJ; pn = L % NJ; }
    const int l = lane_id();
    const bool le = (l >= 1 && l < 32) ? ((int)tstart[l & 31] <= tt) : false;
    e = __builtin_popcountll(__ballot(le)); return true;
}
struct MoeOrder {
    const PG8_LAS unsigned* tstart; const PG8_LAS unsigned* rowmap; int NJ, G, c; bool gather; size_t b_estride;
    __device__ __forceinline__ bool next(int i, Unit& u) const {
        int tt, pn, e; const bool ok = moe_unit(tstart, NJ, G, c, i, tt, pn, e);
        if (!__builtin_amdgcn_readfirstlane((int)ok)) return false;
        u.pm = __builtin_amdgcn_readfirstlane(tt); u.pn = __builtin_amdgcn_readfirstlane(pn); u.ui = i; u.e = __builtin_amdgcn_readfirstlane(e); return true;
    }
    __device__ __forceinline__ void a_offs(const Gemm& g, const Unit& u, const int (&R)[2], const int (&C)[2], unsigned (&va)[2][2]) const {
#pragma unroll
        for (int h = 0; h < 2; ++h)
#pragma unroll
            for (int i = 0; i < 2; ++i) { const unsigned row = gather ? rowmap[u.ui * 256 + h * 128 + R[i]] : (unsigned)(u.pm * 256 + h * 128 + R[i]); va[h][i] = (row * (unsigned)g.K + (unsigned)C[i]) * 2u; }
    }
    __device__ __forceinline__ const char* b_base(const Gemm& g, const Unit& u) const { return (const char*)g.Bt + (size_t)u.e * b_estride + (size_t)u.pn * 256 * g.K * 2; }
};
struct EpiUp {
    static constexpr bool PERM = true, AFTER_DRAIN = false; static constexpr int NST = 0;
    unsigned char* HID; const PG8_LAS float* cwt;
    __device__ __forceinline__ void operator()(const f32x4 (&acc)[2][2][4][2], const Unit& u, int wr, int wc, int fr, int fq) const {
        const int col0 = u.pn * HALF + wc * 32 + 8 * fq;
#pragma unroll
        for (int ai = 0; ai < 2; ++ai)
#pragma unroll
            for (int m = 0; m < 4; ++m) { const int r = ai * HALF + wr * 64 + m * 16 + fr; const float cws = cwt[u.ui * 256 + r] * (F8_ASCALE / F8_WSCALE);
                float o[8];
#pragma unroll
                for (int n = 0; n < 2; ++n)
#pragma unroll
                    for (int j = 0; j < 4; ++j) { const float a = acc[ai][0][m][n][j] * (1.f / F8_WSCALE), b = acc[ai][1][m][n][j]; o[4 * n + j] = a * __builtin_amdgcn_rcpf(1.f + __builtin_amdgcn_exp2f(-1.4426950408889634f * a)) * b * cws; }
                u32x2 w; w.x = pk4_fp8(o[0], o[1], o[2], o[3]); w.y = pk4_fp8(o[4], o[5], o[6], o[7]);
                *(u32x2*)(HID + (unsigned)((u.pm * 256 + r) * 512 + col0)) = w; }
    }
};
struct EpiDown {
    static constexpr bool PERM = true, AFTER_DRAIN = false; static constexpr int NST = 0;
    bf16_t* Y2; const PG8_LAS unsigned* rowmap;
    __device__ __forceinline__ void operator()(const f32x4 (&acc)[2][2][4][2], const Unit& u, int wr, int wc, int fr, int fq) const {
        const int col0 = u.pn * BM + wc * 32 + 8 * fq;
#pragma unroll
        for (int ai = 0; ai < 2; ++ai)
#pragma unroll
            for (int m = 0; m < 4; ++m) { const int r = ai * HALF + wr * 64 + m * 16 + fr; const unsigned tg = rowmap[u.ui * 256 + r];
                if (tg != 0xffffffffu) { bf16_t* rowp = Y2 + (unsigned)(tg * 2048u + (unsigned)col0);
#pragma unroll
                    for (int bj = 0; bj < 2; ++bj) { const f32x4 v0 = acc[ai][bj][m][0] * (1.f / (F8_WSCALE * F8_ASCALE)), v1 = acc[ai][bj][m][1] * (1.f / (F8_WSCALE * F8_ASCALE));
                        u32x4 w; w.x = cvt_pk_bf16(v0[0], v0[1]); w.y = cvt_pk_bf16(v0[2], v0[3]); w.z = cvt_pk_bf16(v1[0], v1[1]); w.w = cvt_pk_bf16(v1[2], v1[3]);
                        *(u32x4*)(rowp + bj * HALF) = w; } } }
    }
};
struct StaticOrderG : StaticOrder {
    __device__ __forceinline__ bool next(int i, Unit& u) const { if (!StaticOrder::next(i, u)) return false; u.ui = i; u.e = 0; return true; }
    __device__ __forceinline__ void a_offs(const Gemm& g, const Unit& u, const int (&R)[2], const int (&C)[2], unsigned (&va)[2][2]) const {
#pragma unroll
        for (int h = 0; h < 2; ++h)
#pragma unroll
            for (int i = 0; i < 2; ++i) va[h][i] = ((unsigned)(u.pm * 256 + h * 128 + R[i]) * (unsigned)g.K + (unsigned)C[i]) * 2u;
    }
    __device__ __forceinline__ const char* b_base(const Gemm& g, const Unit& u) const { return (const char*)g.Bt + (size_t)u.pn * 256 * g.K * 2; }
};
struct EpiProjQ {
    static constexpr bool PERM = true, AFTER_DRAIN = false; static constexpr int NST = 16;
    bf16_t* O; int ldc; const float* rs; const unsigned* cmax;
    __device__ __forceinline__ void operator()(const f32x4 (&acc)[2][2][4][2], const Unit& u, int wr, int wc, int fr, int fq) const {
        const int row0 = u.pm * BM + wr * 64 + fr, col0 = u.pn * BM + wc * 32 + 8 * fq;
        const float sc = ((u.pn < 4) ? QA_SCALE : ((u.pn == 12 || u.pn == 13) ? QB_SCALE : 1.f)) * (1.f / 127.f);
        float cs[2][8];
#pragma unroll
        for (int bj = 0; bj < 2; ++bj) { const u32x4 c0 = *(const u32x4*)(cmax + col0 + bj * HALF), c1 = *(const u32x4*)(cmax + col0 + bj * HALF + 4);
#pragma unroll
            for (int j = 0; j < 4; ++j) { cs[bj][j] = __uint_as_float(c0[j]) * sc; cs[bj][4 + j] = __uint_as_float(c1[j]) * sc; } }
        float rr[2][4];
#pragma unroll
        for (int ai = 0; ai < 2; ++ai)
#pragma unroll
            for (int m = 0; m < 4; ++m) rr[ai][m] = rs[row0 + ai * HALF + m * 16];
#pragma unroll
        for (int ai = 0; ai < 2; ++ai)
#pragma unroll
            for (int m = 0; m < 4; ++m) { const int row = row0 + ai * HALF + m * 16; const float r = rr[ai][m]; bf16_t* rowp = O + (size_t)row * ldc + col0;
#pragma unroll
                for (int bj = 0; bj < 2; ++bj) { float v[8];
#pragma unroll
                    for (int j = 0; j < 4; ++j) { v[j] = (float)(int)__float_as_uint(acc[ai][bj][m][0][j]) * r * cs[bj][j]; v[4 + j] = (float)(int)__float_as_uint(acc[ai][bj][m][1][j]) * r * cs[bj][4 + j]; }
                    u32x4 w; w.x = cvt_pk_bf16(v[0], v[1]); w.y = cvt_pk_bf16(v[2], v[3]); w.z = cvt_pk_bf16(v[4], v[5]); w.w = cvt_pk_bf16(v[6], v[7]);
                    *(u32x4*)(rowp + bj * HALF) = w; } }
    }
};
}
#define GAS __attribute__((address_space(1)))
#define LAS __attribute__((address_space(3)))
typedef unsigned short bf16;
typedef unsigned v4u __attribute__((ext_vector_type(4)));
typedef float f32x4 __attribute__((ext_vector_type(4)));
typedef short bf16x8 __attribute__((ext_vector_type(8)));
typedef GAS unsigned gu32;
typedef GAS unsigned long long gu64;
#define RLX_AGENT __ATOMIC_RELAXED, __HIP_MEMORY_SCOPE_AGENT
#define LDS_WAIT() asm volatile("s_waitcnt lgkmcnt(0)" ::: "memory")
#define VM_WAIT() asm volatile("s_waitcnt vmcnt(0)" ::: "memory")
__device__ __forceinline__ unsigned long long rt() { return __builtin_amdgcn_s_memrealtime(); }
__device__ __forceinline__ unsigned f2bf(float f) { unsigned u = __builtin_bit_cast(unsigned, f); return (u + 0x7fffu + ((u >> 16) & 1u)) >> 16; }
__device__ __forceinline__ unsigned pk2(float lo, float hi) { return f2bf(lo) | (f2bf(hi) << 16); }

#define XB_TMO      128
#define XB_XCNT(j)  (256  + 64 * (j))
#define XB_XSUB(j)  (1280 + 64 * (j))
#define XB_XGEN(j)  (2304 + 64 * (j))
#define XB_TOP      3328
#define XB_TOPGEN   3392
#define XCD_BAR_WORDS 3456
#define XB_SPIN_CAP (1u << 18)

__device__ __forceinline__ unsigned xb_ld(unsigned* p)              { return __hip_atomic_load(p, __ATOMIC_RELAXED, __HIP_MEMORY_SCOPE_AGENT); }
__device__ __forceinline__ unsigned xb_add(unsigned* p, unsigned v) { return __hip_atomic_fetch_add(p, v, __ATOMIC_RELAXED, __HIP_MEMORY_SCOPE_AGENT); }
__device__ __forceinline__ unsigned xb_xcc_id() { return (unsigned)__builtin_amdgcn_s_getreg((3 << 11) | 20) & 0xFu; }
#define XB_SPIN(cond, bar) do { unsigned _sp = 0; while (cond) { __builtin_amdgcn_s_sleep(1); \
    if ((++_sp & 255u) == 0u) { if (xb_ld(&(bar)[XB_TMO])) break; if (_sp > XB_SPIN_CAP) { atomicAdd(&(bar)[XB_TMO], 1u); break; } } } } while (0)

struct XcdBarrier {
    unsigned* bar; unsigned x;
    volatile LAS unsigned* st;
};

__device__ __forceinline__ XcdBarrier xcd_barrier_post(unsigned* bar, volatile LAS unsigned* st, bool leader_thread) {
    XcdBarrier b; b.bar = bar; b.x = xb_xcc_id(); b.st = st;
    if (leader_thread) (void)xb_add(&bar[XB_XCNT(b.x)], 1u);
    return b;
}
__device__ __forceinline__ void xcd_barrier_complete(unsigned* bar, unsigned x, unsigned& nloc, unsigned& nx) {
    const unsigned G = gridDim.x * gridDim.y * gridDim.z;
    unsigned sum, cnt, mine, sp = 0u;
    for (;;) {
        sum = 0u; cnt = 0u; mine = 0u;
#pragma unroll
        for (unsigned j = 0; j < 16; ++j) { const unsigned c = xb_ld(&bar[XB_XCNT(j)]); sum += c; cnt += (c > 0u) ? 1u : 0u; mine = (j == x) ? c : mine; }
        if (sum == G) break;
        __builtin_amdgcn_s_sleep(1);
        if ((++sp & 255u) == 0u) { if (xb_ld(&bar[XB_TMO])) break; if (sp > XB_SPIN_CAP) { atomicAdd(&bar[XB_TMO], 1u); break; } }
    }
    nloc = mine > 0u ? mine : 1u; nx = cnt > 0u ? cnt : 1u;
}

__device__ __forceinline__ void xcd_barrier(const XcdBarrier& b, bool leader_thread) {
    asm volatile("s_waitcnt vmcnt(0)" ::: "memory");
    __syncthreads();
    if (leader_thread) {
        unsigned* bar = b.bar;
        __builtin_amdgcn_s_waitcnt(0);
        unsigned nloc = b.st[0], nx = b.st[1];
        if (nloc == 0u) { xcd_barrier_complete(bar, b.x, nloc, nx); b.st[0] = nloc; b.st[1] = nx; }
        const unsigned old = xb_add(&bar[XB_XSUB(b.x)], 1u);
        const unsigned gen = old / nloc;
        if (old + 1u == (gen + 1u) * nloc) {
            __builtin_amdgcn_fence(__ATOMIC_RELEASE, "agent");
            asm volatile("s_waitcnt vmcnt(0)" ::: "memory");
            const unsigned og = xb_add(&bar[XB_TOP], 1u);
            const unsigned tg = og / nx;
            if (og + 1u == (tg + 1u) * nx) xb_add(&bar[XB_TOPGEN], 1u);
            else XB_SPIN(xb_ld(&bar[XB_TOPGEN]) == tg, bar);
            __builtin_amdgcn_fence(__ATOMIC_ACQUIRE, "agent");
            xb_add(&bar[XB_XGEN(b.x)], 1u);
            asm volatile("s_waitcnt vmcnt(0)" ::: "memory");
        } else {
            XB_SPIN(xb_ld(&bar[XB_XGEN(b.x)]) == gen, bar);
            __builtin_amdgcn_fence(__ATOMIC_ACQUIRE, "agent");
            asm volatile("s_waitcnt vmcnt(0)" ::: "memory");
        }
    }
    __syncthreads();
}
typedef unsigned u32x4 __attribute__((ext_vector_type(4)));
__device__ __forceinline__ float bf2f(unsigned b) { return __uint_as_float(b << 16); }
__device__ __forceinline__ float siluf(float x) { return x / (1.f + __expf(-x)); }
__device__ __forceinline__ float ada_get(const float* part, const float* b_ada, int b, int j) {
    float s = b_ada[j];
#pragma unroll
    for (int kq = 0; kq < 4; ++kq) s += part[(size_t)(kq * 4 + b) * NADA + j];
    return s;
}
__device__ __forceinline__ f32x4 ada_get4(const float* part, const float* b_ada, int b, int j) {
    f32x4 s = *(const f32x4*)(b_ada + j);
#pragma unroll
    for (int kq = 0; kq < 4; ++kq) s += *(const f32x4*)(part + (size_t)(kq * 4 + b) * NADA + j);
    return s;
}
__device__ __forceinline__ int t5_bucket(int rel) {
    const int n = rel < 0 ? -rel : rel; const float nf = (float)(n > 1 ? n : 1);
    int large = 8 + (int)(logf(nf / 8.0f) / 3.4657359027997265f * 8.0f); large = large < 15 ? large : 15;
    return (rel > 0 ? 16 : 0) + (n < 8 ? n : large);
}
namespace att {
#define ALAS __attribute__((address_space(3)))
using f32x16 = __attribute__((ext_vector_type(16))) float;
using s16x4 = __attribute__((ext_vector_type(4))) short;
using bf16x8 = __attribute__((ext_vector_type(8))) short;
using u32x4 = __attribute__((ext_vector_type(4))) unsigned;
constexpr int SLOT = 32768, SLOT_V = 16384, NSLOT = 4, TABN = 416, TOFF = 352, OFF_TAB = 131520, OFF_WS = OFF_TAB + 8 * TABN * 4, OFF_MISC = OFF_WS + 2048;
static_assert(OFF_MISC + 64 <= 147456, "attention LDS map");
constexpr float THR = 8.f;
#define KSWZ(row, colB) ((row) * 256 + ((colB) ^ (((row) & 7) << 4)))
#define SBAR() __builtin_amdgcn_sched_barrier(0)
__device__ __forceinline__ int crow(int r, int hi) { return (r & 3) + 8 * (r >> 2) + 4 * hi; }
__device__ __forceinline__ void glds16(const void* gsrc, unsigned lds_dst) {
  asm volatile("s_mov_b32 m0, %1\n\ts_nop 0\n\tglobal_load_lds_dwordx4 %0, off" :: "v"(gsrc), "s"(lds_dst) : "memory"); }
#define WAIT_BAR() asm volatile("s_waitcnt vmcnt(0) lgkmcnt(0)\n\ts_barrier" ::: "memory")
#define ENDSLOT() asm volatile("s_waitcnt vmcnt(4) lgkmcnt(0)\n\ts_barrier" ::: "memory")
__device__ __forceinline__ unsigned cvtpk(float lo, float hi) { unsigned r; asm volatile("v_cvt_pk_bf16_f32 %0, %1, %2" : "=v"(r) : "v"(lo), "v"(hi)); return r; }
__device__ __forceinline__ void partialSM(f32x16& p0, f32x16& p1, float& m_reg, float& mn, float& alpha, const ALAS float* tb, bool near, float bfar, bool kill) {
  if (near) {
#pragma unroll
    for (int r = 0; r < 16; ++r) { p0[r] += tb[(r & 3) + 8 * (r >> 2)]; p1[r] += tb[32 + (r & 3) + 8 * (r >> 2)]; } }
  if (kill) {
#pragma unroll
    for (int r = 0; r < 16; ++r) { p0[r] = -1e30f; p1[r] = -1e30f; } }
  float pmax = p0[0];
#pragma unroll
  for (int r = 1; r < 16; ++r) pmax = fmaxf(pmax, p0[r]);
#pragma unroll
  for (int r = 0; r < 16; ++r) pmax = fmaxf(pmax, p1[r]);
  { auto rr = __builtin_amdgcn_permlane32_swap(__float_as_uint(pmax), __float_as_uint(pmax), false, false);
    pmax = fmaxf(__uint_as_float(rr[0]), __uint_as_float(rr[1])); }
  const float bo = near ? 0.f : bfar;
  pmax += bo;
  if (__builtin_expect(__all(pmax - m_reg <= THR), 1)) { mn = m_reg; alpha = 1.f; }
  else { mn = fmaxf(m_reg, pmax); alpha = __builtin_amdgcn_exp2f(m_reg - mn); m_reg = mn; }
  const float sh = bo - mn;
#pragma unroll
  for (int r = 0; r < 16; ++r) { p0[r] += sh; p1[r] += sh; }
#pragma unroll
  for (int r = 0; r < 16; ++r) p0[r] = __builtin_amdgcn_exp2f(p0[r]);
}
__device__ __forceinline__ void finishSM(f32x16& p0, f32x16& p1, float alpha, float& l_reg, bf16x8& pa0, bf16x8& pa1, bf16x8& pa2, bf16x8& pa3) {
#pragma unroll
  for (int r = 0; r < 16; ++r) p1[r] = __builtin_amdgcn_exp2f(p1[r]);
  float ps = 0;
#pragma unroll
  for (int r = 0; r < 16; ++r) ps += p0[r];
#pragma unroll
  for (int r = 0; r < 16; ++r) ps += p1[r];
  { auto rr = __builtin_amdgcn_permlane32_swap(__float_as_uint(ps), __float_as_uint(ps), false, false);
    ps = __uint_as_float(rr[0]) + __uint_as_float(rr[1]); }
  l_reg = l_reg * alpha + ps;
#define PK4(P, BASE, OUT) do { unsigned a0 = cvtpk(P[BASE + 0], P[BASE + 1]), a1 = cvtpk(P[BASE + 2], P[BASE + 3]);   \
    unsigned b0 = cvtpk(P[BASE + 4], P[BASE + 5]), b1 = cvtpk(P[BASE + 6], P[BASE + 7]);                              \
    auto r0 = __builtin_amdgcn_permlane32_swap(a0, b0, false, false); auto r1 = __builtin_amdgcn_permlane32_swap(a1, b1, false, false); \
    u32x4 w = {r0[0], r1[0], r0[1], r1[1]}; OUT = *reinterpret_cast<bf16x8*>(&w); } while (0)
  PK4(p0, 0, pa0); PK4(p0, 8, pa1); PK4(p1, 0, pa2); PK4(p1, 8, pa3);
#undef PK4
}
__device__ __forceinline__ float psm_pre(f32x16& p0, f32x16& p1, float& m_reg, float& alpha, const ALAS float* tb, bool near, float bfar, bool kill) {
  if (near) {
#pragma unroll
    for (int r = 0; r < 16; ++r) { p0[r] += tb[(r & 3) + 8 * (r >> 2)]; p1[r] += tb[32 + (r & 3) + 8 * (r >> 2)]; } }
  float pmax = p0[0];
#pragma unroll
  for (int r = 1; r < 16; ++r) pmax = fmaxf(pmax, p0[r]);
#pragma unroll
  for (int r = 0; r < 16; ++r) pmax = fmaxf(pmax, p1[r]);
  { auto rr = __builtin_amdgcn_permlane32_swap(__float_as_uint(pmax), __float_as_uint(pmax), false, false);
    pmax = fmaxf(__uint_as_float(rr[0]), __uint_as_float(rr[1])); }
  const float bo = near ? 0.f : bfar;
  pmax = kill ? -1e30f : pmax + bo;
  float mn;
  if (__builtin_expect(__all(pmax - m_reg <= THR), 1)) { mn = m_reg; alpha = 1.f; }
  else { mn = fmaxf(m_reg, pmax); alpha = __builtin_amdgcn_exp2f(m_reg - mn); m_reg = mn; }
  return kill ? -1e30f : bo - mn;
}
__device__ __forceinline__ void finish_plain(const f32x16& p0, const f32x16& p1, float alpha, float& l_reg, bf16x8& pa0, bf16x8& pa1, bf16x8& pa2, bf16x8& pa3) {
  float ps = 0;
#pragma unroll
  for (int r = 0; r < 16; ++r) ps += p0[r];
#pragma unroll
  for (int r = 0; r < 16; ++r) ps += p1[r];
  { auto rr = __builtin_amdgcn_permlane32_swap(__float_as_uint(ps), __float_as_uint(ps), false, false);
    ps = __uint_as_float(rr[0]) + __uint_as_float(rr[1]); }
  l_reg = l_reg * alpha + ps;
#define PK4(P, BASE, OUT) do { unsigned a0 = cvtpk(P[BASE + 0], P[BASE + 1]), a1 = cvtpk(P[BASE + 2], P[BASE + 3]);   \
    unsigned b0 = cvtpk(P[BASE + 4], P[BASE + 5]), b1 = cvtpk(P[BASE + 6], P[BASE + 7]);                              \
    auto r0 = __builtin_amdgcn_permlane32_swap(a0, b0, false, false); auto r1 = __builtin_amdgcn_permlane32_swap(a1, b1, false, false); \
    u32x4 w = {r0[0], r1[0], r0[1], r1[1]}; OUT = *reinterpret_cast<bf16x8*>(&w); } while (0)
  PK4(p0, 0, pa0); PK4(p0, 8, pa1); PK4(p1, 0, pa2); PK4(p1, 8, pa3);
#undef PK4
}
__device__ __forceinline__ void qkt(f32x16& p0, f32x16& p1, const ALAS char* Ks, const bf16x8* qr, int r32, int hi, int cbm) {
  p0 = f32x16{}; p1 = f32x16{};
#pragma unroll
  for (int d0 = 0; d0 < 4; ++d0) { const int cb = cbm + (d0 * 16 + hi * 8) * 2;
    const bf16x8 b0 = *(const ALAS bf16x8*)(Ks + KSWZ(r32, cb));
    const bf16x8 b1 = *(const ALAS bf16x8*)(Ks + KSWZ(32 + r32, cb));
    p0 = __builtin_amdgcn_mfma_f32_32x32x16_bf16(b0, qr[d0], p0, 0, 0, 0);
    p1 = __builtin_amdgcn_mfma_f32_32x32x16_bf16(b1, qr[d0], p1, 0, 0, 0); }
}
__device__ __forceinline__ int v_st(int k, int c) { const int kk = (k & ~0xC) | ((k & 4) << 1) | ((k & 8) >> 1); return ((kk >> 3) * 4 + (c >> 5)) * 512 + ((kk & 7) * 32 + (c & 31)) * 2; }
__device__ __forceinline__ int v_rd_base(int lane) { return ((lane & 3) << 3) | (((lane >> 2) & 3) << 6) | (((lane >> 4) & 1) << 5) | (((lane >> 5) & 1) << 8); }
constexpr int v_rd_off(int d0, int ks, int half) { return d0 * 512 + ks * 4096 + half * 2048; }
template <int OFF> __device__ __forceinline__ s16x4 tr_read(int vb) {
  s16x4 r; asm volatile("ds_read_b64_tr_b16 %0, %1 offset:%2" : "=&v"(r) : "v"(vb), "i"(OFF) : "memory"); return r;
}
#define PK(L, H) (bf16x8){L[0], L[1], L[2], L[3], H[0], H[1], H[2], H[3]}
#define VRD8(D0, l, h) do { l[0] = tr_read<v_rd_off(D0, 0, 0)>(vb); h[0] = tr_read<v_rd_off(D0, 0, 1)>(vb); l[1] = tr_read<v_rd_off(D0, 1, 0)>(vb); h[1] = tr_read<v_rd_off(D0, 1, 1)>(vb); \
    l[2] = tr_read<v_rd_off(D0, 2, 0)>(vb); h[2] = tr_read<v_rd_off(D0, 2, 1)>(vb); l[3] = tr_read<v_rd_off(D0, 3, 0)>(vb); h[3] = tr_read<v_rd_off(D0, 3, 1)>(vb); } while (0)
#define PVM(od, l, h) do { od = __builtin_amdgcn_mfma_f32_32x32x16_bf16(pa0, PK(l[0], h[0]), od, 0, 0, 0); od = __builtin_amdgcn_mfma_f32_32x32x16_bf16(pa1, PK(l[1], h[1]), od, 0, 0, 0); \
    od = __builtin_amdgcn_mfma_f32_32x32x16_bf16(pa2, PK(l[2], h[2]), od, 0, 0, 0); od = __builtin_amdgcn_mfma_f32_32x32x16_bf16(pa3, PK(l[3], h[3]), od, 0, 0, 0); } while (0)
#define PVM2(oa, ob, la_, ha_, lb_, hb_) do { \
    oa = __builtin_amdgcn_mfma_f32_32x32x16_bf16(pa0, PK(la_[0], ha_[0]), oa, 0, 0, 0); ob = __builtin_amdgcn_mfma_f32_32x32x16_bf16(pa0, PK(lb_[0], hb_[0]), ob, 0, 0, 0); \
    oa = __builtin_amdgcn_mfma_f32_32x32x16_bf16(pa1, PK(la_[1], ha_[1]), oa, 0, 0, 0); ob = __builtin_amdgcn_mfma_f32_32x32x16_bf16(pa1, PK(lb_[1], hb_[1]), ob, 0, 0, 0); \
    oa = __builtin_amdgcn_mfma_f32_32x32x16_bf16(pa2, PK(la_[2], ha_[2]), oa, 0, 0, 0); ob = __builtin_amdgcn_mfma_f32_32x32x16_bf16(pa2, PK(lb_[2], hb_[2]), ob, 0, 0, 0); \
    oa = __builtin_amdgcn_mfma_f32_32x32x16_bf16(pa3, PK(la_[3], ha_[3]), oa, 0, 0, 0); ob = __builtin_amdgcn_mfma_f32_32x32x16_bf16(pa3, PK(lb_[3], hb_[3]), ob, 0, 0, 0); } while (0)
__device__ __forceinline__ void pv_d0(f32x16* o, int vb, bf16x8 pa0, bf16x8 pa1, bf16x8 pa2, bf16x8 pa3) {
  s16x4 la[4], ha[4], lb[4], hb[4];
  SBAR();
  VRD8(0, la, ha); VRD8(1, lb, hb);
  asm volatile("s_waitcnt lgkmcnt(0)" ::: "memory"); SBAR(); PVM2(o[0], o[1], la, ha, lb, hb);
  VRD8(2, la, ha); VRD8(3, lb, hb);
  asm volatile("s_waitcnt lgkmcnt(0)" ::: "memory"); SBAR(); PVM2(o[2], o[3], la, ha, lb, hb);
}
template <bool PVON> __device__ __forceinline__ void m_slot(f32x16& c0, f32x16& c1, f32x16* o, int ka, const int (&koff)[4], const bf16x8* qr, int vb, bf16x8 pa0, bf16x8 pa1, bf16x8 pa2, bf16x8 pa3) {
  bf16x8 k0[4], k1[4]; s16x4 la[4], ha[4], lb[4], hb[4];
#define VRKS(KS, L, H) do { L[0] = tr_read<v_rd_off(0, KS, 0)>(vb); H[0] = tr_read<v_rd_off(0, KS, 1)>(vb); L[1] = tr_read<v_rd_off(1, KS, 0)>(vb); H[1] = tr_read<v_rd_off(1, KS, 1)>(vb); \
    L[2] = tr_read<v_rd_off(2, KS, 0)>(vb); H[2] = tr_read<v_rd_off(2, KS, 1)>(vb); L[3] = tr_read<v_rd_off(3, KS, 0)>(vb); H[3] = tr_read<v_rd_off(3, KS, 1)>(vb); } while (0)
#define PVKS(PA, L, H) do { o[0] = __builtin_amdgcn_mfma_f32_32x32x16_bf16(PA, PK(L[0], H[0]), o[0], 0, 0, 0); o[1] = __builtin_amdgcn_mfma_f32_32x32x16_bf16(PA, PK(L[1], H[1]), o[1], 0, 0, 0); \
    o[2] = __builtin_amdgcn_mfma_f32_32x32x16_bf16(PA, PK(L[2], H[2]), o[2], 0, 0, 0); o[3] = __builtin_amdgcn_mfma_f32_32x32x16_bf16(PA, PK(L[3], H[3]), o[3], 0, 0, 0); } while (0)
  SBAR();
#pragma unroll
  for (int d0 = 0; d0 < 4; ++d0) { asm volatile("ds_read_b128 %0, %1" : "=&v"(k0[d0]) : "v"(ka + koff[d0]) : "memory"); asm volatile("ds_read_b128 %0, %1 offset:8192" : "=&v"(k1[d0]) : "v"(ka + koff[d0]) : "memory"); }
  if (PVON) { VRKS(0, la, ha); asm volatile("s_waitcnt lgkmcnt(8)" ::: "memory"); } else asm volatile("s_waitcnt lgkmcnt(0)" ::: "memory");
  SBAR();
  c0 = __builtin_amdgcn_mfma_f32_32x32x16_bf16(k0[0], qr[0], f32x16{}, 0, 0, 0); c1 = __builtin_amdgcn_mfma_f32_32x32x16_bf16(k1[0], qr[0], f32x16{}, 0, 0, 0);
#pragma unroll
  for (int d0 = 1; d0 < 4; ++d0) { c0 = __builtin_amdgcn_mfma_f32_32x32x16_bf16(k0[d0], qr[d0], c0, 0, 0, 0); c1 = __builtin_amdgcn_mfma_f32_32x32x16_bf16(k1[d0], qr[d0], c1, 0, 0, 0); }
  if (PVON) {
    SBAR(); VRKS(1, lb, hb); asm volatile("s_waitcnt lgkmcnt(8)" ::: "memory"); SBAR(); PVKS(pa0, la, ha);
    SBAR(); VRKS(2, la, ha); asm volatile("s_waitcnt lgkmcnt(8)" ::: "memory"); SBAR(); PVKS(pa1, lb, hb);
    SBAR(); VRKS(3, lb, hb); asm volatile("s_waitcnt lgkmcnt(8)" ::: "memory"); SBAR(); PVKS(pa2, la, ha);
    asm volatile("s_waitcnt lgkmcnt(0)" ::: "memory"); SBAR(); PVKS(pa3, lb, hb);
  }
#undef VRKS
#undef PVKS
}
#undef PVM2
#undef PK
#undef VRD8
#undef PVM

template <int abl> __device__ __forceinline__ void attn_unit(const bf16* __restrict__ P, bf16* __restrict__ CAT, const float* __restrict__ g_sub, int b, int h, int u, int wave_id, ALAS char* lds) {
  if (abl & 1024) { __syncthreads(); return; }
  const int lane = lane_id(), wid = wave_id,
  tid = wid * 64 + lane, r32 = lane & 31, hi = lane >> 5, sub = wid >> 1, mp = wid & 1;
  ALAS char* K_lds = lds;
  ALAS float* ws = (ALAS float*)(lds + OFF_WS) + wid * 64; ALAS float* li_l = ws; ALAS float* al_l = ws + 32;
  const ALAS float* tab = (const ALAS float*)(lds + OFF_TAB) + h * TABN;
  const int q0w = u * 128 + sub * 32, NT = 2 * u + 2;
  const bool mask_last = (sub < 2);
  const int jn = (q0w >= 319) ? (q0w - 319) / 64 + 1 : 0;
  const float bfar = tab[TOFF - 256];
  const ALAS float* tb0 = tab + (TOFF - q0w - r32 + 4 * hi);
  const size_t rowb = (size_t)b * SEQ;
  const bf16* Kh = P + rowb * NPROJ + C_KA + h * 128; const bf16* Vh = P + rowb * NPROJ + C_VA + h * 128;
  unsigned ksrc[2], vsrc[2];
#pragma unroll
  for (int i = 0; i < 2; ++i) { const int row = wid * 8 + i * 4 + (lane >> 4), ch = (lane & 15) ^ (row & 7); ksrc[i] = (unsigned)(row * NPROJ + ch * 8) * 2u;
    const int ob = wid * 2048 + i * 1024 + lane * 16, st = ob >> 9, we = (ob & 511) >> 1, kk = 8 * (st >> 2) + (we >> 5), c = 32 * (st & 3) + (we & 31), k = (kk & ~0xC) | ((kk & 4) << 1) | ((kk & 8) >> 1);
    vsrc[i] = (unsigned)(k * NPROJ + c) * 2u; }
  const unsigned ldsb = (unsigned)(uintptr_t)lds, kdst = ldsb + (unsigned)wid * 2048u, vdst = kdst + SLOT_V;
#define DMA_TILE(t, so) do { const char* kg = (const char*)Kh + (size_t)(t) * (64 * NPROJ * 2); const char* vg = (const char*)Vh + (size_t)(t) * (64 * NPROJ * 2); \
    glds16(kg + ksrc[0], (unsigned)__builtin_amdgcn_readfirstlane(kdst + (so))); glds16(kg + ksrc[1], (unsigned)__builtin_amdgcn_readfirstlane(kdst + 1024 + (so))); \
    glds16(vg + vsrc[0], (unsigned)__builtin_amdgcn_readfirstlane(vdst + (so))); glds16(vg + vsrc[1], (unsigned)__builtin_amdgcn_readfirstlane(vdst + 1024 + (so))); } while (0)
  DMA_TILE(0, 0); DMA_TILE(1, SLOT);
  float m_reg = -1e30f, l_reg = 0; f32x16 o[4] = {}; bf16x8 qr[4];
  { const bf16* Qu = P + (rowb + q0w) * NPROJ + C_QA + h * 128 + mp * 64; const unsigned qo = (unsigned)(r32 * NPROJ + hi * 8);
#pragma unroll
    for (int d0 = 0; d0 < 4; ++d0) qr[d0] = *reinterpret_cast<const bf16x8*>(Qu + qo + d0 * 16); }
  const int cbm = mp * 128;
  const int vb0 = (int)ldsb + SLOT_V + v_rd_base(lane);
#define RESC(a) do { if (__any((a) < 1.f)) { if (hi == 0) al_l[r32] = (a); asm volatile("s_waitcnt lgkmcnt(0)" ::: "memory"); \
    _Pragma("unroll") for (int d = 0; d < 4; ++d) _Pragma("unroll") for (int r = 0; r < 16; ++r) o[d][r] *= al_l[crow(r, hi)]; } } while (0)
#define PSM(P0, P1, MN, AL, t) partialSM(P0, P1, m_reg, MN, AL, tb0 + 64 * (t), (t) >= jn, bfar, mask_last && ((t) == NT - 1))
  f32x16 c0, c1; float al = 1.f; bf16x8 pa0 = {}, pa1 = {}, pa2 = {}, pa3 = {};
  int koff[4];
#pragma unroll
  for (int d0 = 0; d0 < 4; ++d0) koff[d0] = KSWZ(r32, cbm + d0 * 32 + hi * 16);
  const bool grpB = (wid >= 4);
#define SLOTOF(t) (((t) & (NSLOT - 1)) * SLOT)
#define MQK(t) do { if (!(abl & 1)) qkt(c0, c1, K_lds + SLOTOF(t), qr, r32, hi, cbm); } while (0)
#define MPV(t) do { if (!(abl & 2)) pv_d0(o, vb0 + SLOTOF(t), pa0, pa1, pa2, pa3); } while (0)
#define VSM(t) do { if (abl & 4) break; const float sh_ = psm_pre(c0, c1, m_reg, al, tb0 + 64 * (t), (t) >= jn, bfar, mask_last && ((t) == NT - 1)); RESC(al); \
    if (!(abl & 8)) { _Pragma("unroll") for (int r = 0; r < 16; ++r) { c0[r] = __builtin_amdgcn_exp2f(c0[r] + sh_); c1[r] = __builtin_amdgcn_exp2f(c1[r] + sh_); } } \
    if (!(abl & 16)) finish_plain(c0, c1, al, l_reg, pa0, pa1, pa2, pa3); } while (0)
#define ENDS(t) do { if ((t) + 2 >= NT) WAIT_BAR(); else ENDSLOT(); } while (0)
  if (2 < NT) DMA_TILE(2, 2 * SLOT);
  WAIT_BAR();
  if (grpB) ENDSLOT();
  MQK(0); if (!grpB && 3 < NT) DMA_TILE(3, 3 * SLOT);
  ENDS(0);
  if (grpB && 3 < NT) DMA_TILE(3, 3 * SLOT);
  VSM(0); ENDS(0);
#pragma unroll 1
  for (int t = 1; t < NT; ++t) {
    if (!grpB && t + 2 < NT && t >= 2) DMA_TILE(t + 2, SLOTOF(t + 2));
    MQK(t); MPV(t - 1); ENDS(t);
    if (grpB && t + 3 < NT) DMA_TILE(t + 3, SLOTOF(t + 3));
    VSM(t); ENDS(t);
  }
  MPV(NT - 1);
  if (!grpB) ENDSLOT();
#undef ENDS
#undef SLOTOF
#undef MQK
#undef MPV
#undef VSM
  if (hi == 0) li_l[r32] = l_reg; asm volatile("s_waitcnt lgkmcnt(0)" ::: "memory");
  float rli[16];
#pragma unroll
  for (int r = 0; r < 16; ++r) rli[r] = __builtin_amdgcn_rcpf(li_l[crow(r, hi)]);
  __syncthreads();
  ALAS float* X = (ALAS float*)lds + sub * 4096 + lane;
  if (mp == 1) {
#pragma unroll
    for (int d0 = 0; d0 < 4; ++d0)
#pragma unroll
      for (int r = 0; r < 16; ++r) X[(d0 * 16 + r) * 64] = o[d0][r] * rli[r]; }
  __syncthreads();
  if (mp == 0) {
    const float lam = *(const ALAS float*)(lds + OFF_MISC);
    float ss[16];
#pragma unroll
    for (int r = 0; r < 16; ++r) ss[r] = 0.f;
#pragma unroll
    for (int d0 = 0; d0 < 4; ++d0)
#pragma unroll
      for (int r = 0; r < 16; ++r) { const float v = o[d0][r] * rli[r] - lam * X[(d0 * 16 + r) * 64]; o[d0][r] = v; ss[r] += v * v; }
#pragma unroll
    for (int r = 0; r < 16; ++r) {
      ss[r] = half_sum(ss[r]);
      ss[r] = rsqrtf(ss[r] * (1.f / 128.f) + EPS) * (1.f - LAM_INIT); }
    bf16* Ou = CAT + (rowb + q0w) * DM + h * 128; const unsigned oo = (unsigned)(4 * hi * DM + r32);
#pragma unroll
    for (int d0 = 0; d0 < 4; ++d0) { const float gd = g_sub[32 * d0 + r32];
#pragma unroll
      for (int r = 0; r < 16; ++r) Ou[oo + (unsigned)(((r & 3) + 8 * (r >> 2)) * DM + 32 * d0)] = (bf16)f2bf(o[d0][r] * ss[r] * gd); }
  }
  __syncthreads();
#undef DMA_TILE
#undef RESC
#undef PSM
}
#undef KSWZ
#undef SBAR
#undef WAIT_BAR
#undef ALAS
}
namespace gla {
#define GLAS __attribute__((address_space(3)))
using f32x16 = __attribute__((ext_vector_type(16))) float;
using s16x4 = __attribute__((ext_vector_type(4))) short;
using bf16x8 = __attribute__((ext_vector_type(8))) short;
typedef float f32x2_t __attribute__((ext_vector_type(2))); typedef __bf16 bf16x2_t __attribute__((ext_vector_type(2)));
__device__ __forceinline__ unsigned cvt2(float lo, float hi) { f32x2_t v = {lo, hi}; bf16x2_t b = __builtin_convertvector(v, bf16x2_t); return __builtin_bit_cast(unsigned, b); }
constexpr int KD_STRIDE = 144, V_STRIDE = 576, Q_STRIDE = 264, GCH = 8;
constexpr size_t GS_SLOT = 131584;
constexpr int OFF_KDT = 0, OFF_V = 18432, OFF_Q = 80960, OFF_DEC = 97856, OFF_TOTP = 98368, OFF_SSP = 99392, OFF_K = 101440, OFF_GN = 118336;
__device__ __forceinline__ int crow(int r, int hi) { return (r & 3) + 8 * (r >> 2) + 4 * hi; }
template <int OFF> __device__ __forceinline__ s16x4 tr_read(int vb) {
  s16x4 r; asm volatile("ds_read_b64_tr_b16 %0, %1 offset:%2" : "=&v"(r) : "v"(vb), "i"(OFF) : "memory"); return r;
}
__device__ __forceinline__ void gla_unit(const bf16* __restrict__ P, const float* __restrict__ ZB, const float* __restrict__ w_alpha, const float* __restrict__ b_alpha, const float* __restrict__ g_norm_b,
                                         bf16* __restrict__ CAT, int b, int hb, int grp, int mode, unsigned char* GS, unsigned* gflags, unsigned* tmo, int wave_id, GLAS char* lds) {
  const int lane = lane_id(), w = wave_id,
  tid = w * 64 + lane, r32 = lane & 31, hi = lane >> 5, cb = w >> 2, db = w & 3;
  GLAS float* dec = (GLAS float*)(lds + OFF_DEC); GLAS float* totp = (GLAS float*)(lds + OFF_TOTP); GLAS float* ssp = (GLAS float*)(lds + OFF_SSP);
  bf16x8 wa;
#pragma unroll
  for (int j = 0; j < 8; ++j) wa[j] = (short)f2bf(w_alpha[(8 * hi + j) * 512 + hb * 128 + 32 * db + r32]);
  const float ba = b_alpha[hb * 128 + 32 * db + r32];
  if (tid < 256) ((GLAS float*)(lds + OFF_GN))[tid] = g_norm_b[tid];
  f32x16 S[4] = {};
  const size_t rowb = (size_t)b * SEQ;
  const int gid = b * 4 + hb;
  if (mode == 1 && grp > 0) {
    if (w == 0) {
      for (int j = 0; j < grp; ++j) { unsigned sp = 0;
        while (__hip_atomic_load(gflags + 64 * (gid * 7 + j), __ATOMIC_RELAXED, __HIP_MEMORY_SCOPE_AGENT) == 0u) { __builtin_amdgcn_s_sleep(4);
          if (++sp > (1u << 21)) { __hip_atomic_store(tmo, 1u, __ATOMIC_RELAXED, __HIP_MEMORY_SCOPE_AGENT); break; } } } }
    __syncthreads();
#pragma unroll 1
    for (int j = 0; j < grp; ++j) {
      const unsigned char* slot = GS + (size_t)(gid * 7 + j) * GS_SLOT;
      if (tid < 128) dec[tid] = __uint_as_float(__hip_atomic_load((const unsigned*)(slot + 131072) + tid, __ATOMIC_RELAXED, __HIP_MEMORY_SCOPE_AGENT));
      unsigned long long Lt[32];
      const unsigned long long* lp = (const unsigned long long*)slot + (size_t)(w * 256 + lane) * 8;
#pragma unroll
      for (int i = 0; i < 32; ++i) Lt[i] = __hip_atomic_load(lp + (i >> 3) * 512 + (i & 7), __ATOMIC_RELAXED, __HIP_MEMORY_SCOPE_AGENT);
      __syncthreads();
#pragma unroll
      for (int dblk = 0; dblk < 4; ++dblk)
#pragma unroll
        for (int g = 0; g < 4; ++g) { const f32x4 dv = *(GLAS f32x4*)(dec + 32 * dblk + 8 * g + 4 * hi);
#pragma unroll
          for (int jj = 0; jj < 4; ++jj) { const unsigned long long t = Lt[dblk * 8 + 2 * g + (jj >> 1)]; const float lv = __uint_as_float((jj & 1) ? (unsigned)(t >> 32) : (unsigned)t);
            S[dblk][4 * g + jj] = S[dblk][4 * g + jj] * dv[jj] + lv; } }
      __syncthreads();
    }
  }
  float Tsum = 0.f;
  const unsigned vo = (unsigned)((tid >> 5) * NPROJ + C_VB + hb * 256 + (tid & 31) * 8), qo = (unsigned)((tid >> 4) * NPROJ + C_QB + hb * 128 + (tid & 15) * 8);
  const unsigned ko = (unsigned)((tid >> 4) * NPROJ + C_KB + hb * 128 + (tid & 15) * 8);
  const unsigned zo = (unsigned)((32 * cb + r32) * 16 + 8 * hi);
  const unsigned ro = (unsigned)(r32 * NPROJ + C_RB + hb * 256 + 32 * w + 4 * hi);
  const int l0 = (int)(unsigned)(uintptr_t)lds;
  int vwr = l0 + OFF_V + (tid >> 5) * V_STRIDE + (tid & 31) * 16, qwr = l0 + OFF_Q + (tid >> 4) * Q_STRIDE + (tid & 15) * 16;
  int kdw = l0 + OFF_KDT + (32 * db + r32) * KD_STRIDE + (32 * cb + 4 * hi) * 2;
  int kwr = l0 + OFF_K + (tid >> 4) * Q_STRIDE + (tid & 15) * 16, krd = l0 + OFF_K + (32 * cb + 4 * hi) * Q_STRIDE + (32 * db + r32) * 2, gnb = l0 + OFF_GN + (32 * w + 4 * hi) * 4;
  int totw = l0 + OFF_TOTP + (cb * 128 + 32 * db + r32) * 4, totr = l0 + OFF_TOTP + (32 * db + r32) * 4, decw = l0 + OFF_DEC + (32 * db + r32) * 4;
  int qb = l0 + OFF_Q + r32 * Q_STRIDE + 8 * hi, kdb = l0 + OFF_KDT + r32 * KD_STRIDE + 16 * hi, decb = l0 + OFF_DEC + 16 * hi, sspb = l0 + OFF_SSP + 4 * r32;
  asm volatile("" : "+v"(vwr), "+v"(qwr), "+v"(kdw), "+v"(qb), "+v"(kdb), "+v"(decb), "+v"(sspb), "+v"(kwr), "+v"(krd), "+v"(gnb), "+v"(totw), "+v"(totr), "+v"(decw));
#define LP(T, a) ((GLAS T*)(unsigned)(a))
  const int i16 = lane & 15, vrd = (int)(unsigned)(uintptr_t)lds + OFF_V + (8 * hi + (i16 >> 2)) * V_STRIDE + (32 * w + 16 * ((lane >> 4) & 1) + 4 * (i16 & 3)) * 2;
  bf16x8 pv[4], pq[2], pk[2]; f32x4 pz[2];
#define GLOADV(n) do { const bf16* Pt = P + (rowb + (size_t)(n) * 64) * NPROJ; \
    _Pragma("unroll") for (int i = 0; i < 4; ++i) pv[i] = *reinterpret_cast<const bf16x8*>(Pt + vo + (unsigned)(16 * i * NPROJ)); } while (0)
#define GLOAD(n) do { const bf16* Pt = P + (rowb + (size_t)(n) * 64) * NPROJ; const float* Zt = ZB + (rowb + (size_t)(n) * 64) * 16; \
    _Pragma("unroll") for (int i = 0; i < 2; ++i) pq[i] = *reinterpret_cast<const bf16x8*>(Pt + qo + (unsigned)(32 * i * NPROJ)); \
    pz[0] = *reinterpret_cast<const f32x4*>(Zt + zo); pz[1] = *reinterpret_cast<const f32x4*>(Zt + zo + 4); \
    _Pragma("unroll") for (int i = 0; i < 2; ++i) pk[i] = *reinterpret_cast<const bf16x8*>(Pt + ko + (unsigned)(32 * i * NPROJ)); } while (0)
  GLOAD(grp * GCH); GLOADV(grp * GCH);
#pragma unroll 1
  for (int nn = 0; nn < GCH; ++nn) {
    const int n = grp * GCH + nn;
    const size_t t0 = rowb + (size_t)n * 64;
    float la[16], Tcb;
    { bf16x8 za; { const unsigned a0 = cvt2(pz[0][0], pz[0][1]), a1 = cvt2(pz[0][2], pz[0][3]), a2 = cvt2(pz[1][0], pz[1][1]), a3 = cvt2(pz[1][2], pz[1][3]);
        u32x4 t = {a0, a1, a2, a3}; za = __builtin_bit_cast(bf16x8, t); }
      f32x16 pre;
#pragma unroll
      for (int r = 0; r < 16; ++r) pre[r] = ba;
      pre = __builtin_amdgcn_mfma_f32_32x32x16_bf16(za, wa, pre, 0, 0, 0);
#pragma unroll
      for (int r = 0; r < 16; ++r) { const float xx = pre[r]; la[r] = (fminf(xx, 0.f) - __logf(1.f + __expf(-fabsf(xx)))) * (1.f / 16.f); }
      float run = 0.f;
#pragma unroll
      for (int g = 0; g < 4; ++g) { la[4 * g + 1] += la[4 * g]; la[4 * g + 2] += la[4 * g + 1]; la[4 * g + 3] += la[4 * g + 2];
        const float G = la[4 * g + 3];
        auto rr = __builtin_amdgcn_permlane32_swap(__float_as_uint(G), __float_as_uint(G), false, false);
        const float G0 = __uint_as_float(rr[0]), G1 = __uint_as_float(rr[1]);
        const float off = run + (hi ? G0 : 0.f);
        la[4 * g] += off; la[4 * g + 1] += off; la[4 * g + 2] += off; la[4 * g + 3] += off; run += G0 + G1; }
      Tcb = run;
      if (hi == 0) *LP(float, totw) = Tcb; }
#pragma unroll
    for (int i = 0; i < 4; ++i) *LP(bf16x8, vwr + 16 * i * V_STRIDE) = pv[i];
    if (mode)
#pragma unroll
    for (int i = 0; i < 2; ++i) { const u32x4 t = __builtin_bit_cast(u32x4, pq[i]); *LP(u32x2, qwr + 32 * i * Q_STRIDE) = (u32x2){t.x, t.y}; *LP(u32x2, qwr + 32 * i * Q_STRIDE + 8) = (u32x2){t.z, t.w}; }
#pragma unroll
    for (int i = 0; i < 2; ++i) { const u32x4 t = __builtin_bit_cast(u32x4, pk[i]); *LP(u32x2, kwr + 32 * i * Q_STRIDE) = (u32x2){t.x, t.y}; *LP(u32x2, kwr + 32 * i * Q_STRIDE + 8) = (u32x2){t.z, t.w}; }
    __syncthreads();
    { const float t0v = *LP(float, totr), t1v = *LP(float, totr + 512), total = t0v + t1v, base = cb ? t0v : 0.f;
#pragma unroll
      for (int g = 0; g < 4; ++g) { float kd[4];
#pragma unroll
        for (int j = 0; j < 4; ++j) kd[j] = __uint_as_float((unsigned)(*LP(unsigned short, krd + (8 * g + j) * Q_STRIDE)) << 16) * __expf(total - (la[4 * g + j] + base));
        *LP(u32x2, kdw + 16 * g) = (u32x2){cvt2(kd[0], kd[1]), cvt2(kd[2], kd[3])}; }
      Tsum += total;
      if (cb == 0 && hi == 0) *LP(float, decw) = __expf(total); }
    __syncthreads();
    if (nn + 1 < GCH) GLOAD(n + 1);
    bf16x8 vf[4];
    { s16x4 lo[4], hh[4];
      lo[0] = tr_read<0>(vrd); hh[0] = tr_read<4 * V_STRIDE>(vrd); lo[1] = tr_read<16 * V_STRIDE>(vrd); hh[1] = tr_read<20 * V_STRIDE>(vrd);
      lo[2] = tr_read<32 * V_STRIDE>(vrd); hh[2] = tr_read<36 * V_STRIDE>(vrd); lo[3] = tr_read<48 * V_STRIDE>(vrd); hh[3] = tr_read<52 * V_STRIDE>(vrd);
      asm volatile("s_waitcnt lgkmcnt(0)" ::: "memory"); __builtin_amdgcn_sched_barrier(0);
#pragma unroll
      for (int s = 0; s < 4; ++s) vf[s] = (bf16x8){lo[s][0], lo[s][1], lo[s][2], lo[s][3], hh[s][0], hh[s][1], hh[s][2], hh[s][3]}; }
    f32x16 z[2] = {};
#pragma unroll
    for (int dblk = 0; dblk < 4; ++dblk) {
#pragma unroll
      for (int g = 0; g < 4; ++g) { const f32x4 dv = *LP(f32x4, decb + 128 * dblk + 32 * g);
#pragma unroll
        for (int j = 0; j < 4; ++j) S[dblk][4 * g + j] *= dv[j]; }
#pragma unroll
      for (int s = 0; s < 4; ++s) { const bf16x8 af = *LP(bf16x8, kdb + 32 * dblk * KD_STRIDE + 32 * s);
        S[dblk] = __builtin_amdgcn_mfma_f32_32x32x16_bf16(af, vf[s], S[dblk], 0, 0, 0); }
      if (mode)
#pragma unroll
      for (int s2 = 0; s2 < 2; ++s2) {
        const u32x4 xt = {cvt2(S[dblk][8 * s2], S[dblk][8 * s2 + 1]), cvt2(S[dblk][8 * s2 + 2], S[dblk][8 * s2 + 3]), cvt2(S[dblk][8 * s2 + 4], S[dblk][8 * s2 + 5]), cvt2(S[dblk][8 * s2 + 6], S[dblk][8 * s2 + 7])};
        const bf16x8 xs = __builtin_bit_cast(bf16x8, xt);
#pragma unroll
        for (int cblk = 0; cblk < 2; ++cblk) { const int qa = qb + 32 * cblk * Q_STRIDE + 64 * dblk + 32 * s2;
          const u32x2 q0 = *LP(u32x2, qa), q1 = *LP(u32x2, qa + 16);
          const u32x4 qt = {q0.x, q0.y, q1.x, q1.y};
          z[cblk] = __builtin_amdgcn_mfma_f32_32x32x16_bf16(xs, __builtin_bit_cast(bf16x8, qt), z[cblk], 0, 0, 0); } }
      __builtin_amdgcn_sched_barrier(0);
    }
    if (nn + 1 < GCH) GLOADV(n + 1);
    if (mode) {
    u32x2 rbv[2][4];
    { const bf16* Rt = P + t0 * NPROJ;
#pragma unroll
      for (int cblk = 0; cblk < 2; ++cblk)
#pragma unroll
        for (int g = 0; g < 4; ++g) rbv[cblk][g] = *reinterpret_cast<const u32x2*>(Rt + ro + (unsigned)(32 * cblk * NPROJ + 8 * g)); }
#pragma unroll
    for (int cblk = 0; cblk < 2; ++cblk) { float s = 0.f;
#pragma unroll
      for (int r = 0; r < 16; ++r) s += z[cblk][r] * z[cblk][r];
      auto rr = __builtin_amdgcn_permlane32_swap(__float_as_uint(s), __float_as_uint(s), false, false);
      s = __uint_as_float(rr[0]) + __uint_as_float(rr[1]);
      if (hi == 0) *LP(float, sspb + 256 * w + 128 * cblk) = s; }
    __syncthreads();
#pragma unroll
    for (int cblk = 0; cblk < 2; ++cblk) { float tot = 0.f;
#pragma unroll
      for (int ww = 0; ww < 8; ++ww) tot += *LP(float, sspb + 256 * ww + 128 * cblk);
      const float rs = rsqrtf(tot * (1.f / 256.f) + EPS);
      bf16* Ot = CAT + (t0 + 32 * cblk + r32) * DM + 1024 + hb * 256 + 32 * w + 4 * hi;
#pragma unroll
      for (int g = 0; g < 4; ++g) { const u32x2 rw = rbv[cblk][g]; float o4[4]; const f32x4 gq = *LP(f32x4, gnb + 32 * g);
        const float r0 = __uint_as_float(rw.x << 16), r1 = __uint_as_float(rw.x & 0xffff0000u), r2 = __uint_as_float(rw.y << 16), r3 = __uint_as_float(rw.y & 0xffff0000u);
#define GLA_SILU(v) ((v) * __builtin_amdgcn_rcpf(1.f + __builtin_amdgcn_exp2f(-1.4426950408889634f * (v))))
        o4[0] = z[cblk][4 * g] * rs * gq[0] * GLA_SILU(r0); o4[1] = z[cblk][4 * g + 1] * rs * gq[1] * GLA_SILU(r1);
        o4[2] = z[cblk][4 * g + 2] * rs * gq[2] * GLA_SILU(r2); o4[3] = z[cblk][4 * g + 3] * rs * gq[3] * GLA_SILU(r3);
#undef GLA_SILU
        *reinterpret_cast<u32x2*>(Ot + 8 * g) = (u32x2){cvt2(o4[0], o4[1]), cvt2(o4[2], o4[3])}; } }
    }
  }
  if (mode == 0) {
    unsigned char* slot = GS + (size_t)(gid * 7 + grp) * GS_SLOT;
    const int lane2 = lane_id(), r32 = lane2 & 31, hi = lane2 >> 5;
    unsigned long long* lp = (unsigned long long*)slot + (size_t)(w * 256 + lane2) * 8;
#pragma unroll
    for (int dblk = 0; dblk < 4; ++dblk)
#pragma unroll
      for (int i = 0; i < 8; ++i) __hip_atomic_store(lp + dblk * 512 + i, ((unsigned long long)__float_as_uint(S[dblk][2 * i + 1]) << 32) | (unsigned long long)__float_as_uint(S[dblk][2 * i]), __ATOMIC_RELAXED, __HIP_MEMORY_SCOPE_AGENT);
    if (cb == 0 && hi == 0) __hip_atomic_store((unsigned*)(slot + 131072) + 32 * db + r32, __float_as_uint(__expf(Tsum)), __ATOMIC_RELAXED, __HIP_MEMORY_SCOPE_AGENT);
    asm volatile("s_waitcnt vmcnt(0)" ::: "memory");
    __syncthreads();
    if (w == 0 && lane2 == 0) __hip_atomic_store(gflags + 64 * (gid * 7 + grp), 1u, __ATOMIC_RELAXED, __HIP_MEMORY_SCOPE_AGENT);
  }
  __syncthreads();
#undef GLOAD
#undef GLOADV
#undef LP
}
#undef GLAS
}
constexpr int NWAVES = 8;
constexpr int RING_OFF = 0, RING_BYTES = 131072;
constexpr int LDSCTL_OFF = RING_BYTES, MISC_OFF = LDSCTL_OFF + 320;
constexpr int LDS_BYTES = 147456;
constexpr int CW_CNT = 0;
constexpr int CW_BAR = 4096;
constexpr int N_PHASES = 9;
struct Frame {
    LAS unsigned char* lds;
    volatile LAS unsigned* MISC;
    gu32* ctl;
    int wave, G;
};
struct Args { const float* in[26]; float* out; unsigned char* ws; int ph_lo, ph_hi, li, pad; };

__device__ __forceinline__ void p0_ada_item(Frame& F, const float* __restrict__ c, const float* __restrict__ w_ada, float* __restrict__ part, int it) {
    const int lane = lane_id(), tid = F.wave * 64 + lane;
    const int jc = it % 48, kq = it / 48, j0 = jc * 256 + 4 * lane, k0 = kq * 512 + F.wave * 64;
    float s[4];
#pragma unroll
    for (int b = 0; b < 4; ++b) { const float cv = c[b * DM + k0 + lane]; s[b] = cv / (1.f + __expf(-cv)); }
    f32x4 acc[4];
#pragma unroll
    for (int b = 0; b < 4; ++b) acc[b] = (f32x4){0.f, 0.f, 0.f, 0.f};
#pragma unroll 16
    for (int i = 0; i < 64; ++i) { const f32x4 w = *(const GAS f32x4*)(w_ada + (size_t)(k0 + i) * NADA + j0);
#pragma unroll
        for (int b = 0; b < 4; ++b) acc[b] += w * __shfl(s[b], i); }
    LAS float* red = (LAS float*)(F.lds + RING_OFF);
#pragma unroll
    for (int b = 0; b < 4; ++b) *(LAS f32x4*)(red + (F.wave * 4 + b) * 256 + 4 * lane) = acc[b];
    __syncthreads();
    for (int o = tid; o < 1024; o += NWAVES * 64) { float t = 0.f;
#pragma unroll
        for (int w = 0; w < 8; ++w) t += red[w * 1024 + o];
        part[(size_t)(kq * 4 + (o >> 8)) * NADA + jc * 256 + (o & 255)] = t; }
    __syncthreads();
}
__device__ __forceinline__ void p0_transpose_item(const float* __restrict__ W, int K, int Ncols, int ldw, bf16* __restrict__ WT, int rs_hi, int off, LAS float* scr, int item, int lane) {
    const int nblk = Ncols / 32, kb = item / nblk, nb = item % nblk, k0 = 64 * kb, n0 = 32 * nb;
#pragma unroll
    for (int i = 0; i < 32; ++i) { const int kk = 2 * i + (lane >> 5); scr[kk * 33 + (lane & 31)] = W[(size_t)(k0 + kk) * ldw + n0 + (lane & 31)]; }
    LDS_WAIT(); asm volatile("" ::: "memory");
    const int c = lane & 7;
#pragma unroll
    for (int j = 0; j < 4; ++j) { const int nl = (lane >> 3) + 8 * j, n = n0 + nl; const LAS float* s = scr + (8 * c) * 33 + nl;
        v4u o; o.x = pk2(s[0 * 33], s[1 * 33]); o.y = pk2(s[2 * 33], s[3 * 33]); o.z = pk2(s[4 * 33], s[5 * 33]); o.w = pk2(s[6 * 33], s[7 * 33]);
        const int row = (n >> 7) * rs_hi + off + (n & 127);
        *(GAS v4u*)(WT + (size_t)row * K + k0 + 8 * c) = o; }
    LDS_WAIT(); asm volatile("" ::: "memory");
}
__device__ __forceinline__ void p0_transpose_item_f8(const float* __restrict__ W, int K, int Ncols, int ldw, unsigned char* __restrict__ WT, int rs_hi, int off, LAS float* scr, int item, int lane) {
    const int nblk = Ncols / 32, kb = item / nblk, nb = item % nblk, k0 = 64 * kb, n0 = 32 * nb;
#pragma unroll
    for (int i = 0; i < 32; ++i) { const int kk = 2 * i + (lane >> 5); scr[kk * 33 + (lane & 31)] = W[(size_t)(k0 + kk) * ldw + n0 + (lane & 31)]; }
    LDS_WAIT(); asm volatile("" ::: "memory");
    const int c = lane & 3;
#pragma unroll
    for (int j = 0; j < 2; ++j) { const int nl = (lane >> 2) + 16 * j, n = n0 + nl; const LAS float* s = scr + (16 * c) * 33 + nl;
        v4u o; o.x = pk4_fp8(s[0 * 33] * F8_WSCALE, s[1 * 33] * F8_WSCALE, s[2 * 33] * F8_WSCALE, s[3 * 33] * F8_WSCALE); o.y = pk4_fp8(s[4 * 33] * F8_WSCALE, s[5 * 33] * F8_WSCALE, s[6 * 33] * F8_WSCALE, s[7 * 33] * F8_WSCALE);
        o.z = pk4_fp8(s[8 * 33] * F8_WSCALE, s[9 * 33] * F8_WSCALE, s[10 * 33] * F8_WSCALE, s[11 * 33] * F8_WSCALE); o.w = pk4_fp8(s[12 * 33] * F8_WSCALE, s[13 * 33] * F8_WSCALE, s[14 * 33] * F8_WSCALE, s[15 * 33] * F8_WSCALE);
        const int row = (n >> 7) * rs_hi + off + (n & 127);
        *(GAS v4u*)(WT + (size_t)row * K + k0 + 16 * c) = o; }
    LDS_WAIT(); asm volatile("" ::: "memory");
}
__device__ __forceinline__ void p0_colmax_item(const float* __restrict__ W, int Ncols, int ldw, unsigned* __restrict__ cmax, int item, int lane) {
    const int nblk = Ncols / 32, kb = item / nblk, nb = item % nblk, k0 = 64 * kb, n0 = 32 * nb;
    float m = 0.f;
#pragma unroll
    for (int i = 0; i < 32; ++i) { const int kk = 2 * i + (lane >> 5); m = fmaxf(m, fabsf(W[(size_t)(k0 + kk) * ldw + n0 + (lane & 31)])); }
    auto rr = __builtin_amdgcn_permlane32_swap(__float_as_uint(m), __float_as_uint(m), false, false);
    m = fmaxf(__uint_as_float(rr[0]), __uint_as_float(rr[1]));
    if (lane < 32) __hip_atomic_fetch_max(cmax + n0 + lane, __float_as_uint(m), __ATOMIC_RELAXED, __HIP_MEMORY_SCOPE_AGENT);
}
__device__ __forceinline__ void p1_wq_item(const float* __restrict__ W, int K, int Ncols, int ldw, const unsigned* __restrict__ cmax, unsigned char* __restrict__ WT, LAS float* scr, int item, int lane) {
    const int nblk = Ncols / 32, kb = item / nblk, nb = item % nblk, k0 = 64 * kb, n0 = 32 * nb;
#pragma unroll
    for (int i = 0; i < 32; ++i) { const int kk = 2 * i + (lane >> 5); scr[kk * 33 + (lane & 31)] = W[(size_t)(k0 + kk) * ldw + n0 + (lane & 31)]; }
    LDS_WAIT(); asm volatile("" ::: "memory");
    const int c = lane & 3;
#pragma unroll
    for (int j = 0; j < 2; ++j) { const int nl = (lane >> 2) + 16 * j, n = n0 + nl; const LAS float* s = scr + (16 * c) * 33 + nl;
        const float qs = 127.f / fmaxf(__uint_as_float(cmax[n]), 1e-30f);
        v4u o; o.x = pk4_i8(s[0 * 33], s[1 * 33], s[2 * 33], s[3 * 33], qs); o.y = pk4_i8(s[4 * 33], s[5 * 33], s[6 * 33], s[7 * 33], qs);
        o.z = pk4_i8(s[8 * 33], s[9 * 33], s[10 * 33], s[11 * 33], qs); o.w = pk4_i8(s[12 * 33], s[13 * 33], s[14 * 33], s[15 * 33], qs);
        *(GAS v4u*)(WT + (size_t)n * K + k0 + 16 * c) = o; }
    LDS_WAIT(); asm volatile("" ::: "memory");
}
__device__ __forceinline__ void p0_prologue(Frame& F, const Args& a) {
    const int lane = lane_id();
    unsigned char* ws = a.ws;
    for (int it = blockIdx.x; it < 192; it += F.G) p0_ada_item(F, a.in[1], a.in[3], (float*)(ws + WS_ADAP), it);
    { const int gw0 = blockIdx.x * NWAVES + F.wave, n16 = lane & 15, g4 = lane >> 4;
      if (gw0 < 192) { const int w = gw0 / 24, s = (gw0 / 3) % 8, cb = gw0 % 3, n = 16 * cb + n16, k0 = 256 * w + 32 * s + 8 * g4;
          const float* pp = (n < 4) ? (a.in[19] + (size_t)k0 * 4 + n) : (a.in[21] + (size_t)k0 * 32 + ((n < 36) ? n - 4 : 0)); const int st = (n < 4) ? 4 : 32; const float vv = (n < 36) ? 1.f : 0.f;
          const v4u t = {cvt2bf(pp[0] * vv, pp[st] * vv), cvt2bf(pp[2 * st] * vv, pp[3 * st] * vv), cvt2bf(pp[4 * st] * vv, pp[5 * st] * vv), cvt2bf(pp[6 * st] * vv, pp[7 * st] * vv)};
          *(GAS v4u*)(ws + WS_FRAGR + ((size_t)gw0 * 64 + lane) * 16) = t; }
      else if (gw0 < 256) { const int i = gw0 - 192, w = i / 8, s = i % 8, k0 = 256 * w + 32 * s + 8 * g4; const float* pp = a.in[7] + (size_t)k0 * D_IN + NPROJ + n16;
          const v4u t = {cvt2bf(pp[0], pp[D_IN]), cvt2bf(pp[2 * D_IN], pp[3 * D_IN]), cvt2bf(pp[4 * D_IN], pp[5 * D_IN]), cvt2bf(pp[6 * D_IN], pp[7 * D_IN])};
          *(GAS v4u*)(ws + WS_FRAGZ + ((size_t)i * 64 + lane) * 16) = t; } }
    LAS float* scr = (LAS float*)(F.lds + RING_OFF + F.wave * 16384);
    const int gw = blockIdx.x * NWAVES + F.wave, NGW = F.G * NWAVES;
    constexpr int I_IN = (DM / 64) * (NPROJ / 32), I_OUT = (DM / 64) * (DM / 32), I_E = (DM / 64) * (DEXP / 32);
    constexpr int NITEMS = I_IN + I_OUT + 2 * NEXP * I_E;
    for (int it = gw; it < NITEMS; it += NGW) {
        int r = it;
        if (r < I_IN) { p0_colmax_item(a.in[7], NPROJ, D_IN, (unsigned*)(ws + WS_CTL) + CW_CMAX, r, lane); continue; } r -= I_IN;
        if (r < I_OUT) { p0_transpose_item(a.in[16], DM, DM, DM, (bf16*)(ws + WS_WOUT), 128, 0, scr, r, lane); continue; } r -= I_OUT;
        if (r < NEXP * I_E) { const int e = r / I_E; p0_transpose_item_f8(a.in[23] + (size_t)e * DM * DEXP, DM, DEXP, DEXP, (unsigned char*)(ws + WS_WUP) + (size_t)e * 1024 * DM, 256, 0, scr, r % I_E, lane); continue; } r -= NEXP * I_E;
        { const int e = r / I_E; p0_transpose_item_f8(a.in[24] + (size_t)e * DM * DEXP, DM, DEXP, DEXP, (unsigned char*)(ws + WS_WUP) + (size_t)e * 1024 * DM, 256, 128, scr, r % I_E, lane); }
    }
}

constexpr int T_STRIDE = 4112;
constexpr int P1_T = 0, P1_RED = 66048, P1_A1 = 74240, P1_A0 = 82432;
__device__ __forceinline__ void p1_prenorm(Frame& F, const Args& a) {
    const int lane = lane_id(), tid = F.wave * 64 + lane;
    const float* __restrict__ x = a.in[0]; const float* __restrict__ w_in = a.in[7]; const float* __restrict__ g = a.in[5];
    const float* part = (const float*)(a.ws + WS_ADAP); const float* b_ada = a.in[4];
    unsigned char* H = (unsigned char*)(a.ws + WS_H); float* RS = (float*)(a.ws + WS_RS); float* ZB = (float*)(a.ws + WS_ZB);
    LAS unsigned char* T = F.lds + RING_OFF + P1_T; LAS float* red = (LAS float*)(F.lds + RING_OFF + P1_RED);
    LAS float* A1 = (LAS float*)(F.lds + RING_OFF + P1_A1); LAS float* A0 = (LAS float*)(F.lds + RING_OFF + P1_A0);
    const int rows_per_blk = M / F.G, row_base = blockIdx.x * rows_per_blk, b = row_base / SEQ;
#pragma unroll
    for (int col_k = 0; col_k < DM / (NWAVES * 64); ++col_k) if (const int col = tid + col_k * NWAVES * 64; true) { const float sh = ada_get(part, b_ada, b, col), sc = ada_get(part, b_ada, b, DM + col); A1[col] = g[col] * (1.f + sc); A0[col] = sh; }
    const int n16 = lane & 15, g4 = lane >> 4;
    bf16x8 bz[8];
#pragma unroll
    for (int s = 0; s < 8; ++s) bz[s] = __builtin_bit_cast(bf16x8, *(const GAS v4u*)(a.ws + WS_FRAGZ + ((size_t)(F.wave * 8 + s) * 64 + lane) * 16));
    __syncthreads();
#define P1_LOAD(V, mrow) do { _Pragma("unroll") for (int j = 0; j < 8; ++j) V[j] = *(const GAS f32x4*)(x + (size_t)(mrow) * DM + 256 * j + 4 * lane); } while (0)
#define P1_PROC(V, mrow, lr) do { float ss = 0.f; \
        _Pragma("unroll") for (int j = 0; j < 8; ++j) ss += V[j].x * V[j].x + V[j].y * V[j].y + V[j].z * V[j].z + V[j].w * V[j].w; \
        const float r = rsqrtf(wave_sum(ss) * (1.f / DM) + EPS); \
        float am = 0.f; \
        _Pragma("unroll") for (int j = 0; j < 8; ++j) { const int col = 256 * j + 4 * lane; const f32x4 a1 = *(LAS f32x4*)(A1 + col), a0 = *(LAS f32x4*)(A0 + col); \
            const f32x4 h = V[j] * r * a1 + a0; V[j] = h; am = fmaxf(fmaxf(am, fmaxf(fabsf(h.x), fabsf(h.y))), fmaxf(fabsf(h.z), fabsf(h.w))); u32x2 o; o.x = pk2(h.x, h.y); o.y = pk2(h.z, h.w); \
            *(LAS u32x2*)(T + (lr) * T_STRIDE + col * 2) = o; } \
        am = fmaxf(wave_max(am), 1e-30f); const float qs = 127.f / am; \
        _Pragma("unroll") for (int j = 0; j < 8; ++j) *(GAS unsigned*)(H + (size_t)(mrow) * DM + 256 * j + 4 * lane) = pk4_i8(V[j].x, V[j].y, V[j].z, V[j].w, qs); \
        if (lane == 0) RS[mrow] = am * (1.f / 127.f); } while (0)
    f32x4 va[8], vb[8];
    P1_LOAD(va, row_base + 2 * F.wave);
    for (int t = 0; t < rows_per_blk / 16; ++t) {
        const int r0 = row_base + 16 * t;
        P1_LOAD(vb, r0 + 2 * F.wave + 1);
        P1_PROC(va, r0 + 2 * F.wave, 2 * F.wave);
        if (t + 1 < rows_per_blk / 16) P1_LOAD(va, r0 + 16 + 2 * F.wave);
        P1_PROC(vb, r0 + 2 * F.wave + 1, 2 * F.wave + 1);
        __syncthreads();
        f32x4 acc = (f32x4){0.f, 0.f, 0.f, 0.f};
#pragma unroll
        for (int s = 0; s < 8; ++s) { const bf16x8 af = *(LAS bf16x8*)(T + n16 * T_STRIDE + (256 * F.wave + 32 * s + 8 * g4) * 2); acc = __builtin_amdgcn_mfma_f32_16x16x32_bf16(af, bz[s], acc, 0, 0, 0); }
#pragma unroll
        for (int r = 0; r < 4; ++r) red[(F.wave * 16 + 4 * g4 + r) * 16 + n16] = acc[r];
        __syncthreads();
        if (tid < 256) { float s = 0.f;
#pragma unroll
            for (int w = 0; w < 8; ++w) s += red[w * 256 + tid];
            ZB[(size_t)(r0 + (tid >> 4)) * 16 + (tid & 15)] = s; }
    }
    __syncthreads();
#undef P1_LOAD
#undef P1_PROC
    { LAS float* scr = (LAS float*)(F.lds + RING_OFF + F.wave * 16384); const int gw = blockIdx.x * NWAVES + F.wave, NGW = F.G * NWAVES;
      for (int it = gw; it < (DM / 64) * (NPROJ / 32); it += NGW) p1_wq_item(w_in, DM, NPROJ, D_IN, (const unsigned*)(a.ws + WS_CTL) + CW_CMAX, a.ws + WS_WIN, scr, it, lane_id()); }
}


constexpr int P5_RED = 66048, P5_G1 = 90624, P5_B1 = 98816, P5_B0 = 107008, P5_LG = 115200;
__device__ __forceinline__ void p5_mid(Frame& F, const Args& a, int alt) {
    const int lane = lane_id(), tid = F.wave * 64 + lane;
    const float* __restrict__ x = a.in[0]; bf16* Y = (bf16*)(a.ws + WS_Y); unsigned char* H2 = (unsigned char*)(a.ws + WS_H2);
    const float* part = (const float*)(a.ws + WS_ADAP); const float* b_ada = a.in[4]; const float* g_post = a.in[6]; const float* g_pre = a.in[17];
    const float* __restrict__ w_rg = a.in[19]; const float* b_rg = a.in[20]; const float* __restrict__ w_re = a.in[21]; const float* b_re = a.in[22];
    unsigned* cnt = (unsigned*)(F.ctl + CW_CNT) + (alt ? 256 : 0) + 32 * (blockIdx.x & 7u); unsigned* list = (unsigned*)(a.ws + (alt ? WS_END : WS_LIST)); float* lw = (float*)(a.ws + (alt ? WS_END + 2 * MiB : WS_LW));
    LAS unsigned char* T = F.lds + RING_OFF; LAS float* red = (LAS float*)(F.lds + RING_OFF + P5_RED);
    LAS float* G1 = (LAS float*)(F.lds + RING_OFF + P5_G1); LAS float* B1 = (LAS float*)(F.lds + RING_OFF + P5_B1); LAS float* B0 = (LAS float*)(F.lds + RING_OFF + P5_B0); LAS float* lg = (LAS float*)(F.lds + RING_OFF + P5_LG);
    const int rows_per_blk = M / F.G, row_base = blockIdx.x * rows_per_blk, b = row_base / SEQ;
#pragma unroll 2
    for (int col_k = 0; col_k < DM / (NWAVES * 64); ++col_k) if (const int col = tid + col_k * NWAVES * 64; true) { const float gt = ada_get(part, b_ada, b, 2 * DM + col), sh = ada_get(part, b_ada, b, 3 * DM + col), sc = ada_get(part, b_ada, b, 4 * DM + col);
        G1[col] = gt * g_post[col]; B1[col] = g_pre[col] * (1.f + sc); B0[col] = sh; }
    const int n16 = lane & 15, g4 = lane >> 4;
    bf16x8 bw[8][3];
#pragma unroll
    for (int s = 0; s < 8; ++s)
#pragma unroll
        for (int cb = 0; cb < 3; ++cb) bw[s][cb] = __builtin_bit_cast(bf16x8, *(const GAS v4u*)(a.ws + WS_FRAGR + ((size_t)((F.wave * 8 + s) * 3 + cb) * 64 + lane) * 16));
    __syncthreads();
#define P5_LOAD(YW, mrow) do { _Pragma("unroll") for (int j = 0; j < 8; ++j) YW[j] = *(const GAS u32x2*)(Y + (size_t)(mrow) * DM + 256 * j + 4 * lane); } while (0)
#define P5_PROC(YW, mrow, lr) do { f32x4 xv[8], XV[8]; float ss = 0.f; \
        _Pragma("unroll") for (int j = 0; j < 8; ++j) XV[j] = *(const GAS f32x4*)(x + (size_t)(mrow) * DM + 256 * j + 4 * lane); \
        _Pragma("unroll") for (int j = 0; j < 8; ++j) { const u32x2 w = YW[j]; \
            xv[j] = (f32x4){__uint_as_float(w.x << 16), __uint_as_float(w.x & 0xffff0000u), __uint_as_float(w.y << 16), __uint_as_float(w.y & 0xffff0000u)}; \
            ss += xv[j].x * xv[j].x + xv[j].y * xv[j].y + xv[j].z * xv[j].z + xv[j].w * xv[j].w; } \
        const float ry = rsqrtf(wave_sum(ss) * (1.f / DM) + EPS); float ss2 = 0.f; \
        _Pragma("unroll") for (int j = 0; j < 8; ++j) { const int col = 256 * j + 4 * lane; const f32x4 g1 = *(LAS f32x4*)(G1 + col); \
            xv[j] = XV[j] + g1 * (xv[j] * ry); { u32x2 o1; o1.x = cvt2bf(xv[j].x, xv[j].y); o1.y = cvt2bf(xv[j].z, xv[j].w); *(GAS u32x2*)(Y + (size_t)(mrow) * DM + col) = o1; } \
            ss2 += xv[j].x * xv[j].x + xv[j].y * xv[j].y + xv[j].z * xv[j].z + xv[j].w * xv[j].w; } \
        const float rx = rsqrtf(wave_sum(ss2) * (1.f / DM) + EPS); \
        _Pragma("unroll") for (int j = 0; j < 8; ++j) { const int col = 256 * j + 4 * lane; const f32x4 b1 = *(LAS f32x4*)(B1 + col), b0 = *(LAS f32x4*)(B0 + col); \
            const f32x4 h = xv[j] * rx * b1 + b0; u32x2 o; o.x = pk2(h.x, h.y); o.y = pk2(h.z, h.w); \
            *(GAS unsigned*)(H2 + (size_t)(mrow) * DM + col) = pk4_fp8(h.x, h.y, h.z, h.w); *(LAS u32x2*)(T + (lr) * T_STRIDE + col * 2) = o; } } while (0)
    u32x2 ya[8], yb[8];
    P5_LOAD(ya, row_base + 2 * F.wave);
    for (int t = 0; t < rows_per_blk / 16; ++t) {
        const int r0 = row_base + 16 * t;
        P5_LOAD(yb, r0 + 2 * F.wave + 1);
        P5_PROC(ya, r0 + 2 * F.wave, 2 * F.wave);
        if (t + 1 < rows_per_blk / 16) P5_LOAD(ya, r0 + 16 + 2 * F.wave);
        P5_PROC(yb, r0 + 2 * F.wave + 1, 2 * F.wave + 1);
        __syncthreads();
        f32x4 acc[3];
#pragma unroll
        for (int cb = 0; cb < 3; ++cb) acc[cb] = (f32x4){0.f, 0.f, 0.f, 0.f};
#pragma unroll
        for (int s = 0; s < 8; ++s) { const bf16x8 af = *(LAS bf16x8*)(T + n16 * T_STRIDE + (256 * F.wave + 32 * s + 8 * g4) * 2);
#pragma unroll
            for (int cb = 0; cb < 3; ++cb) acc[cb] = __builtin_amdgcn_mfma_f32_16x16x32_bf16(af, bw[s][cb], acc[cb], 0, 0, 0); }
#pragma unroll
        for (int cb = 0; cb < 3; ++cb)
#pragma unroll
            for (int r = 0; r < 4; ++r) red[(F.wave * 16 + 4 * g4 + r) * 48 + 16 * cb + n16] = acc[cb][r];
        __syncthreads();
        for (int o = tid; o < 768; o += NWAVES * 64) { float s = 0.f; const int n = o % 48;
#pragma unroll
            for (int w = 0; w < 8; ++w) s += red[w * 768 + o];
            lg[t * 768 + o] = s + ((n < 4) ? b_rg[n] : ((n < 36) ? b_re[n - 4] : 0.f)); }
    }
    LAS unsigned* lcnt = (LAS unsigned*)(F.lds + RING_OFF + P5_RED);
    __syncthreads();
    if (tid < 64) lcnt[tid] = 0u;
    __syncthreads();
    unsigned ea = 0u, eb = 0u, pa = 0u, pb = 0u; float wa_ = 0.f, wb_ = 0.f;
    if (tid < rows_per_blk) {
        const LAS float* L = lg + tid * 48;
        int gi = 0; float gm = L[0];
        for (int i = 1; i < 4; ++i) if (L[i] > gm) { gm = L[i]; gi = i; }
        float gs = 0.f; for (int i = 0; i < 4; ++i) gs += __expf(L[i] - gm);
        const float gval = 1.f / gs;
        const LAS float* E = L + 4 + 8 * gi;
        int e1 = 0; float m1 = E[0];
        for (int i = 1; i < 8; ++i) if (E[i] > m1) { m1 = E[i]; e1 = i; }
        int e2 = 0; float m2 = -3.0e38f;
        for (int i = 0; i < 8; ++i) if (i != e1 && E[i] > m2) { m2 = E[i]; e2 = i; }
        const float p2 = __expf(m2 - m1), inv = 1.f / (1.f + p2);
        ea = (unsigned)(gi * 8 + e1); eb = (unsigned)(gi * 8 + e2); wa_ = gval * inv; wb_ = gval * p2 * inv;
        pa = __hip_atomic_fetch_add(lcnt + ea, 1u, __ATOMIC_RELAXED, __HIP_MEMORY_SCOPE_WORKGROUP); pb = __hip_atomic_fetch_add(lcnt + eb, 1u, __ATOMIC_RELAXED, __HIP_MEMORY_SCOPE_WORKGROUP);
    }
    __syncthreads();
    if (tid < 32) { const unsigned c = lcnt[tid]; lcnt[32 + tid] = c ? atomicAdd(&cnt[tid], c) : 0u; }
    __syncthreads();
    if (tid < rows_per_blk) { const int m = row_base + tid; pa += lcnt[32 + ea] + 2048u * (blockIdx.x & 7u); pb += lcnt[32 + eb] + 2048u * (blockIdx.x & 7u);
        list[(size_t)ea * LISTCAP + pa] = (unsigned)(m * 2); lw[(size_t)ea * LISTCAP + pa] = wa_;
        list[(size_t)eb * LISTCAP + pb] = (unsigned)(m * 2 + 1); lw[(size_t)eb * LISTCAP + pb] = wb_; }
    __syncthreads();
#undef P5_LOAD
#undef P5_PROC
}


__device__ __forceinline__ int q_steal(gu32* qh, int x0, int nq) {
    unsigned hd[8];
#pragma unroll
    for (int k = 1; k < 8; ++k) hd[k] = __hip_atomic_load(qh + 64 * ((x0 + k) & 7), __ATOMIC_RELAXED, __HIP_MEMORY_SCOPE_AGENT);
#pragma unroll
    for (int k = 1; k < 8; ++k) { const int x = (x0 + k) & 7; if (hd[k] >= (unsigned)nq) continue;
        const unsigned id = __hip_atomic_fetch_add(qh + 64 * x, 1u, __ATOMIC_RELAXED, __HIP_MEMORY_SCOPE_AGENT); if (id < (unsigned)nq) return x * 256 + (int)id; }
    return -1;
}
__device__ __forceinline__ int q_pop(gu32* qh, int x0, int nq) {
    const unsigned id = __hip_atomic_fetch_add(qh + 64 * (x0 & 7), 1u, __ATOMIC_RELAXED, __HIP_MEMORY_SCOPE_AGENT); if (id < (unsigned)nq) return (x0 & 7) * 256 + (int)id;
    return q_steal(qh, x0, nq);
}
constexpr int CW_W2 = 1024;
__device__ __forceinline__ void p6_tail_w2(Frame& F, const Args& a) {
    const int lane = lane_id(), tid = F.wave * 64 + lane;
    LAS float* scr = (LAS float*)(F.lds + RING_OFF + F.wave * 16384);
    constexpr int I_E = (DEXP / 64) * (DM / 32), NBI = NEXP * I_E / NWAVES;
    const int x0 = (int)(blockIdx.x & 7u); gu32* qh = F.ctl + CW_W2;
    if (tid == 0) F.MISC[16] = (unsigned)q_pop(qh, x0, NBI / 8);
    __syncthreads();
    int it = (int)F.MISC[16]; bool own = true;
    __syncthreads();
    while (it >= 0) {
        unsigned idn = 0xffffffffu;
        if (tid == 0 && own) idn = __hip_atomic_fetch_add(qh + 64 * x0, 1u, __ATOMIC_RELAXED, __HIP_MEMORY_SCOPE_AGENT);
        { const int r = it * NWAVES + F.wave, e = r / I_E;
          p0_transpose_item_f8(a.in[25] + (size_t)e * DM * DEXP, DEXP, DM, DM, (unsigned char*)(a.ws + WS_WDN) + (size_t)e * DM * DEXP, 128, 0, scr, r % I_E, lane); }
        if (tid == 0) { int got = -1; if (own) { if (idn < (unsigned)(NBI / 8)) got = x0 * 256 + (int)idn; else own = false; } if (got < 0) got = q_steal(qh, x0, NBI / 8); F.MISC[16] = (unsigned)got; }
        __syncthreads();
        it = (int)F.MISC[16];
        __syncthreads();
    }
}

constexpr int TAB_OFF = MISC_OFF + 128;
static_assert(TAB_OFF % 16 == 0 && TAB_OFF + 192 + 2 * pg8::MOE_MAXU * 1024 <= LDS_BYTES, "LDS tables");
__device__ __forceinline__ void moe_tables(Frame& F, const Args& a, int NJ, bool down) {
    const int tid = F.wave * 64 + lane_id();
    const unsigned* cnt = (const unsigned*)(F.ctl + CW_CNT); const unsigned* list = (const unsigned*)(a.ws + WS_LIST); const float* lw = (const float*)(a.ws + WS_LW);
    LAS unsigned* tstart = (LAS unsigned*)(F.lds + TAB_OFF); LAS unsigned* rowmap = tstart + 48; LAS float* cwt = (LAS float*)(rowmap + pg8::MOE_MAXU * 256);
    LAS unsigned* sub = (LAS unsigned*)(F.lds + RING_OFF); LAS unsigned* tot = sub + 256;
    if (tid < 256) sub[tid] = cnt[tid];
    __syncthreads();
    if (tid < 32) { unsigned n = 0; for (int j = 0; j < 8; ++j) n += sub[32 * j + tid]; tot[tid] = n; }
    __syncthreads();
    if (tid == 0) { unsigned s = 0; for (int e = 0; e < NEXP; ++e) { tstart[e] = s; s += (tot[e] + 255u) >> 8; } tstart[32] = s;
        unsigned ok = 0u;
        tstart[33] = ok; }
    __syncthreads();
    unsigned idx[3], ent[3]; float wv[3]; bool val[3], has[3];
#pragma unroll
    for (int k = 0; k < 3; ++k) { has[k] = false; val[k] = false; idx[k] = 0u; }
#pragma unroll
    for (int i = 0; i < pg8::MOE_MAXU; ++i) {
        int tt, pn, e; const bool ok = pg8::moe_unit((const LAS unsigned*)tstart, NJ, F.G, (int)blockIdx.x, i, tt, pn, e);
        if (ok && (i & 1) == (tid >> 8)) { const int k = i >> 1; const unsigned n = tot[e];
            const unsigned slot = (unsigned)(tt - (int)tstart[e]) * 256u + (unsigned)(tid & 255); const bool valid = slot < n; unsigned sl = valid ? slot : n - 1u, base = 0u;
#pragma unroll
            for (int j = 0; j < 7; ++j) { const unsigned cj = sub[32 * j + e]; const bool nxt = sl >= cj && base == 2048u * j; if (nxt) { sl -= cj; base += 2048u; } }
            has[k] = true; val[k] = valid; idx[k] = (unsigned)e * (unsigned)LISTCAP + sl + base; }
    }
#pragma unroll
    for (int k = 0; k < 3; ++k) { ent[k] = has[k] ? list[idx[k]] : 0u; wv[k] = has[k] ? lw[idx[k]] : 0.f; }
#pragma unroll
    for (int k = 0; k < 3; ++k) if (has[k]) { const int i = 2 * k + (tid >> 8), r = tid & 255;
        rowmap[i * 256 + r] = down ? (val[k] ? (ent[k] & 1u) * (unsigned)M + (ent[k] >> 1) : 0xffffffffu) : (ent[k] >> 1);
        cwt[i * 256 + r] = val[k] ? wv[k] : 0.f; }
    __syncthreads();
}

__device__ __forceinline__ void p8_final(Frame& F, const Args& a, int dummy) {
    const int lane = lane_id(), tid = F.wave * 64 + lane;
    const bf16* __restrict__ Y2 = (const bf16*)(a.ws + WS_Y2); const bf16* __restrict__ X1 = (const bf16*)(a.ws + WS_Y); float* outw = dummy ? (float*)(a.ws + WS_WUP) : a.out; const float* part = (const float*)(a.ws + WS_ADAP); const float* b_ada = a.in[4]; const float* g_post = a.in[18];
    LAS float* G1 = (LAS float*)(F.lds + RING_OFF);
    const int rows_per_blk = M / F.G, row_base = blockIdx.x * rows_per_blk, b = row_base / SEQ;
#pragma unroll
    for (int col_k = 0; col_k < DM / (NWAVES * 64); ++col_k) if (const int col = tid + col_k * NWAVES * 64; true) G1[col] = ada_get(part, b_ada, b, 5 * DM + col) * g_post[col];
    __syncthreads();
#define P8_LOAD(W0, W1, OV, mrow) do { _Pragma("unroll") for (int j = 0; j < 8; ++j) { const int col = 256 * j + 4 * lane; W0[j] = *(const GAS u32x2*)(Y2 + (size_t)(mrow) * DM + col); \
        W1[j] = *(const GAS u32x2*)(Y2 + ((size_t)M + (mrow)) * DM + col); OV[j] = *(const GAS u32x2*)(X1 + (size_t)(mrow) * DM + col); } } while (0)
#define P8_PROC(W0, W1, OV, mrow) do { f32x4 yv[8]; float ss = 0.f; \
        _Pragma("unroll") for (int j = 0; j < 8; ++j) { const u32x2 w0 = W0[j], w1 = W1[j]; \
            yv[j] = (f32x4){__uint_as_float(w0.x << 16) + __uint_as_float(w1.x << 16), __uint_as_float(w0.x & 0xffff0000u) + __uint_as_float(w1.x & 0xffff0000u), \
                            __uint_as_float(w0.y << 16) + __uint_as_float(w1.y << 16), __uint_as_float(w0.y & 0xffff0000u) + __uint_as_float(w1.y & 0xffff0000u)}; \
            ss += yv[j].x * yv[j].x + yv[j].y * yv[j].y + yv[j].z * yv[j].z + yv[j].w * yv[j].w; } \
        const float r = rsqrtf(wave_sum(ss) * (1.f / DM) + EPS); \
        _Pragma("unroll") for (int j = 0; j < 8; ++j) { const int col = 256 * j + 4 * lane; const f32x4 g1 = *(LAS f32x4*)(G1 + col); const u32x2 xw = OV[j]; const f32x4 x1v = (f32x4){__uint_as_float(xw.x << 16), __uint_as_float(xw.x & 0xffff0000u), __uint_as_float(xw.y << 16), __uint_as_float(xw.y & 0xffff0000u)}; \
            *(GAS f32x4*)(outw + (size_t)(mrow) * DM + col) = x1v + g1 * (yv[j] * r); } } while (0)
    { u32x2 a0[8], a1[8], b0[8], b1[8], ao[8], bo[8];
      const int m0 = row_base + F.wave, npair = rows_per_blk / (2 * NWAVES);
      P8_LOAD(a0, a1, ao, m0);
#pragma unroll 1
      for (int it = 0; it < npair; ++it) {
          P8_LOAD(b0, b1, bo, m0 + NWAVES * (2 * it + 1));
          P8_PROC(a0, a1, ao, m0 + NWAVES * (2 * it));
          if (it + 1 < npair) P8_LOAD(a0, a1, ao, m0 + NWAVES * (2 * it + 2));
          P8_PROC(b0, b1, bo, m0 + NWAVES * (2 * it + 1));
      } }
#undef P8_LOAD
#undef P8_PROC
    __syncthreads();
}


constexpr int CW_GF = 65536;
constexpr int CW_Q = 2048;
constexpr int NQ_ATT = 158;
__device__ __forceinline__ void p3_mixer(Frame& F, const Args& a, LAS char* ldsg, int qset, int mode, int abl) {
    const int tid = F.wave * 64 + lane_id();
    const bf16* P = (const bf16*)(a.ws + WS_PROJ); bf16* CAT = (bf16*)(a.ws + WS_CAT);
    const float* rel_bias = a.in[2];
    LAS float* tab = (LAS float*)(ldsg + att::OFF_TAB); LAS float* miscf = (LAS float*)(ldsg + att::OFF_MISC); LAS int* qw = (LAS int*)(ldsg + att::OFF_MISC + 16);
    for (int idx = tid; idx < 8 * att::TABN; idx += NWAVES * 64) { const int h = idx / att::TABN; int rel = idx % att::TABN - att::TOFF; rel = rel < -256 ? -256 : rel;
        tab[idx] = rel_bias[t5_bucket(rel) * 8 + h] * LOG2E; }
    const int x0 = (int)(xb_xcc_id() & 7u);
    if (tid < 64) { const float d1 = wave_sum(a.in[10][tid] * a.in[11][tid]), d2 = wave_sum(a.in[12][tid] * a.in[13][tid]);
        if (tid == 0) miscf[0] = __expf(d1) - __expf(d2) + LAM_INIT; }
    if (tid == 0) { qw[0] = q_pop(F.ctl + CW_Q + 512 * qset, x0, (mode == 1) ? 128 : ((mode == 2) ? 30 : ((mode == 3) ? 64 : NQ_ATT))); }
    __syncthreads();
    int cur = qw[0], par = 1;
    {
        gu32* qh = F.ctl + CW_Q + 512 * qset; const int nq = (mode == 1) ? 128 : ((mode == 2) ? 30 : ((mode == 3) ? 64 : NQ_ATT));
        unsigned char* GS = a.ws + WS_GLA; unsigned* gfl = (unsigned*)(F.ctl + CW_GF) + 8192 * qset; unsigned* tmo = (unsigned*)(F.ctl + CW_BAR) + XB_TMO;
        while (cur >= 0) {
            if (tid == 0) qw[par] = q_pop(qh, x0, nq);
            const int x = cur >> 8, id = cur & 255;
            int kind, k;
            if (mode == 1 || mode == 3) { kind = 2; k = id; } else if (mode == 2) { kind = id < 14 ? 0 : 1; k = id < 14 ? id : id - 14; }
            else if (id < 14) { kind = 0; k = id; } else if (id < 46) { kind = 2; k = id - 14; } else if (id < 62) { kind = 1; k = id - 46; } else { kind = 2; k = id - 30; }
            if (kind == 2) { const int u = 31 - (k >> 2), bh = x * 4 + (k & 3);
#if defined(PROBE_ABL) && PROBE_ABL != 0
                if (abl) att::attn_unit<PROBE_ABL>(P, (bf16*)(a.ws + WS_END), a.in[14], bh >> 3, bh & 7, u, F.wave, ldsg); else
#endif
                att::attn_unit<0>(P, CAT, a.in[14], bh >> 3, bh & 7, u, F.wave, ldsg); }
            else { const int gid = 2 * x + (kind ? (k >> 3) : (k / 7)), grp = kind ? (k & 7) : (k % 7);
                gla::gla_unit(P, (const float*)(a.ws + WS_ZB), a.in[8], a.in[9], a.in[15], CAT, gid >> 2, gid & 3, grp, kind, GS + (size_t)qset * 0, gfl, tmo, F.wave, ldsg); }
            cur = qw[par]; par ^= 1;
        }
    }
    __syncthreads();
}

__global__ void __launch_bounds__(NWAVES * 64, 2) mega_fwd(Args args) {
    extern __shared__ __attribute__((aligned(16))) unsigned char lds[];
    Frame F;
    F.lds = (LAS unsigned char*)lds;
    F.MISC = (volatile LAS unsigned*)(F.lds + MISC_OFF);
    F.wave = __builtin_amdgcn_readfirstlane((int)threadIdx.x >> 6);
    F.G = gridDim.x;
    unsigned char* ws = args.ws;
    F.ctl = (gu32*)(ws + WS_CTL);
    { const int tid = F.wave * 64 + lane_id(); for (int u = tid; u < (LDS_BYTES - LDSCTL_OFF) / 4; u += NWAVES * 64) ((LAS unsigned*)(F.lds + LDSCTL_OFF))[u] = 0u; }
    __syncthreads();
    const int lo = args.ph_lo, hi = args.ph_hi;
    const bool use_bar = (hi - lo) > 1;
    XcdBarrier bar; bar.bar = (unsigned*)(F.ctl + CW_BAR) + args.li * XCD_BAR_WORDS; bar.x = 0; bar.st = nullptr;
    if (use_bar) bar = xcd_barrier_post((unsigned*)(F.ctl + CW_BAR) + args.li * XCD_BAR_WORDS, F.MISC + 8, F.wave == 0 && lane_id() == 0);
#define IN(k) (lo <= (k) && (k) < hi)
#define BOTH(k) (IN(k) && IN((k) + 1))
#ifdef PROBE_BAR2
#define GRID_BAR() do { xcd_barrier(bar, F.wave == 0 && lane_id() == 0); xcd_barrier(bar, F.wave == 0 && lane_id() == 0); xcd_barrier(bar, F.wave == 0 && lane_id() == 0); } while (0)
#else
#define GRID_BAR() xcd_barrier(bar, F.wave == 0 && lane_id() == 0)
#endif
#ifndef PROBE_DUP
#define PROBE_DUP (-1)
#endif
#define NREP(k) ((PROBE_DUP == (k)) ? 2 : 1)
#define REP(k) for (int rep_ = 0; rep_ < NREP(k); ++rep_)
#define SEAM(k) do { if (BOTH(k) || rep_ + 1 < NREP(k)) GRID_BAR(); } while (0)
    if (IN(0)) REP(0) { p0_prologue(F, args); SEAM(0); }
    if (IN(1)) REP(1) { p1_prenorm(F, args); SEAM(1); }
    if (IN(2)) REP(2) {
        pg8::Gemm g{(const bf16*)(ws + WS_H), (const bf16*)(ws + WS_WIN), M, NPROJ, DM / 2}; pg8::StaticOrderG S; S.init(M, NPROJ, F.G, (int)blockIdx.x);
        pg8::EpiProjQ E{(bf16*)(ws + WS_PROJ), NPROJ, (const float*)(ws + WS_RS), (const unsigned*)(ws + WS_CTL) + CW_CMAX};
        pg8::gemm_phase_g<pg8::EpiProjQ, pg8::StaticOrderG, 2>(F.lds + RING_OFF, g, S, E, F.wave);
        SEAM(2);
    }
    if (IN(3)) REP(3) { p3_mixer(F, args, (LAS char*)(F.lds + RING_OFF), (args.pad & 3) + rep_, (args.pad >> 2) & 3, args.pad >> 4); SEAM(3); }
    if (IN(4)) REP(4) {
        pg8::Gemm g{(const bf16*)(ws + WS_CAT), (const bf16*)(ws + WS_WOUT), M, DM, DM}; pg8::StaticOrderG S; S.init(M, DM, F.G, (int)blockIdx.x);
        pg8::EpiPlain E{(bf16*)(ws + WS_Y), DM};
        pg8::gemm_phase_g<pg8::EpiPlain, pg8::StaticOrderG, 0>(F.lds + RING_OFF, g, S, E, F.wave);
        SEAM(4);
    }
    if (IN(5)) REP(5) { p5_mid(F, args, NREP(5) - 1 - rep_); SEAM(5); }
    if (IN(6)) REP(6) {
        moe_tables(F, args, 4, false);
        const pg8::Gemm g{(const bf16*)(ws + WS_H2), (const bf16*)(ws + WS_WUP), 0, 0, DM / 2};
        const pg8::MoeOrder S{(const LAS unsigned*)(F.lds + TAB_OFF), (const LAS unsigned*)(F.lds + TAB_OFF + 192), 4, F.G, (int)blockIdx.x, true, (size_t)1024 * DM};
        const pg8::EpiUp E{(unsigned char*)(ws + WS_HID), (const LAS float*)(F.lds + TAB_OFF + 192 + pg8::MOE_MAXU * 1024)};
        pg8::gemm_phase_g<pg8::EpiUp, pg8::MoeOrder, true>(F.lds + RING_OFF, g, S, E, F.wave);
        p6_tail_w2(F, args);
        SEAM(6);
    }
    if (IN(7)) REP(7) {
        moe_tables(F, args, 8, true);
        const pg8::Gemm g{(const bf16*)(ws + WS_HID), (const bf16*)(ws + WS_WDN), 0, 0, DEXP / 2};
        const pg8::MoeOrder S{(const LAS unsigned*)(F.lds + TAB_OFF), (const LAS unsigned*)(F.lds + TAB_OFF + 192), 8, F.G, (int)blockIdx.x, false, (size_t)DM * DEXP};
        const pg8::EpiDown E{(bf16*)(ws + WS_Y2), (const LAS unsigned*)(F.lds + TAB_OFF + 192)};
        pg8::gemm_phase_g<pg8::EpiDown, pg8::MoeOrder, true>(F.lds + RING_OFF, g, S, E, F.wave);
        SEAM(7);
    }
    if (IN(8)) REP(8) { p8_final(F, args, NREP(8) - 1 - rep_); SEAM(8); }
#undef IN
#undef BOTH
}
static void launch_mega(const Args& a0, int lo, int hi, int li, int grid, hipStream_t stream, int p3opt = 0) {
    Args a = a0; a.ph_lo = lo; a.ph_hi = hi; a.li = li; a.pad = p3opt;
    hipLaunchKernelGGL(mega_fwd, dim3(grid), dim3(NWAVES * 64), LDS_BYTES, stream, a);
    const hipError_t le = hipPeekAtLastError();
    if (le != hipSuccess) fprintf(stderr, "kernel_launch: mega launch [%d,%d) failed: %s\n", lo, hi, hipGetErrorName(le));
}
extern "C" void kernel_launch(void* const* d_in, const int* in_sizes, int n_in, void* d_out, int out_size, void* d_ws, size_t ws_size, hipStream_t stream) {
    static int grid = 0;
    if (grid == 0) {
        if (n_in != 26 || in_sizes[0] != M * DM || out_size != M * DM || ws_size < WS_END) { fprintf(stderr, "kernel_launch: unexpected shapes (n_in %d, in0 %d, out %d, ws %zu < %zu)\n", n_in, n_in > 0 ? in_sizes[0] : -1, out_size, ws_size, (size_t)WS_END); grid = -1; return; }
        int dev = 0, cus = 0;
        if (hipGetDevice(&dev) != hipSuccess || hipDeviceGetAttribute(&cus, hipDeviceAttributeMultiprocessorCount, dev) != hipSuccess) { grid = -1; return; }
        if (hipFuncSetAttribute((const void*)mega_fwd, hipFuncAttributeMaxDynamicSharedMemorySize, LDS_BYTES) != hipSuccess) { fprintf(stderr, "kernel_launch: hipFuncSetAttribute failed\n"); grid = -1; return; }
        int per_cu = 0;
        if (hipOccupancyMaxActiveBlocksPerMultiprocessor(&per_cu, (const void*)mega_fwd, NWAVES * 64, LDS_BYTES) != hipSuccess || per_cu < 1) fprintf(stderr, "kernel_launch: occupancy query reports %d\n", per_cu);
        (void)hipGetLastError();
        grid = cus;
        if (grid != 256) { fprintf(stderr, "kernel_launch: built for 256 CUs, found %d\n", cus); grid = -1; return; }
    }
    if (grid < 0) return;
    const float* x = (const float*)d_in[0]; const float* rel_bias = (const float*)d_in[2]; const float* b_ada = (const float*)d_in[4];
    const float* g_post_mix = (const float*)d_in[6]; const float* w_alpha = (const float*)d_in[8]; const float* b_alpha = (const float*)d_in[9];
    const float* lq1 = (const float*)d_in[10]; const float* lk1 = (const float*)d_in[11]; const float* lq2 = (const float*)d_in[12]; const float* lk2 = (const float*)d_in[13];
    const float* g_sub_a = (const float*)d_in[14]; const float* g_norm_b = (const float*)d_in[15]; const float* g_pre_ffn = (const float*)d_in[17]; const float* g_post_ffn = (const float*)d_in[18];
    const float* w_rg = (const float*)d_in[19]; const float* b_rg = (const float*)d_in[20]; const float* w_re = (const float*)d_in[21]; const float* b_re = (const float*)d_in[22];
    char* ws = (char*)d_ws; float* out = (float*)d_out;
    unsigned* cnt = (unsigned*)(ws + WS_CTL); float* adap = (float*)(ws + WS_ADAP); float* ZB = (float*)(ws + WS_ZB); unsigned* list = (unsigned*)(ws + WS_LIST); float* lw = (float*)(ws + WS_LW);
    bf16* Wup = (bf16*)(ws + WS_WUP); bf16* Wdn = (bf16*)(ws + WS_WDN);
    bf16* CAT = (bf16*)(ws + WS_CAT); bf16* PROJ = (bf16*)(ws + WS_PROJ); bf16* Y = (bf16*)(ws + WS_Y); bf16* H2 = (bf16*)(ws + WS_H2); bf16* Y2 = (bf16*)(ws + WS_Y2); bf16* HID = (bf16*)(ws + WS_HID);
    (void)hipMemsetAsync(ws + WS_CTL, 0, 1 * MiB, stream);
    Args a{};
    for (int i = 0; i < 26; ++i) a.in[i] = (const float*)d_in[i];
    a.out = out; a.ws = (unsigned char*)d_ws;
#ifndef PROBE_LAUNCHES
    launch_mega(a, 0, N_PHASES, 0, grid, stream);
#else
    for (int p = 0; p < N_PHASES; ++p) { launch_mega(a, p, p + 1, p, grid, stream);
        if (p == 3 && PROBE_LAUNCHES > 0) launch_mega(a, 3, 4, 9, grid, stream, 1 + 4 * ((PROBE_LAUNCHES - 1) & 3) + 16 * ((PROBE_LAUNCHES - 1) >> 2)); }
#endif
}
```

```cpp
#include <hip/hip_runtime.h>
#include <cstdio>
#include <cstdint>
typedef unsigned u32x2 __attribute__((ext_vector_type(2)));
constexpr int BATCH = 4, SEQ = 4096, DM = 2048, M = BATCH * SEQ;
constexpr int D_IN = 6160, NPROJ = 6144;
constexpr int NADA = 6 * DM;
constexpr int NEXP = 32, DEXP = 512, LISTCAP = M;
constexpr float EPS = 1e-6f;
constexpr float LOG2E = 1.4426950408889634f;
constexpr float QA_SCALE = 0.125f * LOG2E;
constexpr float QB_SCALE = 0.08838834764831845f;
constexpr float LAM_INIT = 0.2f;
constexpr int C_QA = 0, C_KA = 1024, C_VA = 2048, C_QB = 3072, C_KB = 3584, C_VB = 4096, C_RB = 5120;

constexpr size_t MiB = 1u << 20;
constexpr size_t WS_CTL = 0;
constexpr size_t WS_ADAP = 1 * MiB;
constexpr size_t WS_FRAGR = 1 * MiB + 768 * 1024;
constexpr size_t WS_FRAGZ = WS_FRAGR + 192 * 1024;
constexpr size_t WS_ZB = 2 * MiB;
constexpr size_t WS_LIST = 3 * MiB;
constexpr size_t WS_LW = 5 * MiB;
constexpr size_t WS_RS = 7 * MiB;
constexpr int CW_CMAX = 131072;
constexpr size_t WS_WIN = 8 * MiB;
constexpr size_t WS_WOUT = 32 * MiB;
constexpr size_t WS_WUP = 40 * MiB;
constexpr size_t WS_WDN = 168 * MiB;
constexpr size_t WS_H = 232 * MiB;
constexpr size_t WS_CAT = 296 * MiB;
constexpr size_t WS_PROJ = 360 * MiB;
constexpr size_t WS_Y2 = WS_PROJ;
constexpr size_t WS_HID = WS_PROJ + 128 * MiB;
constexpr size_t WS_GLA = 552 * MiB;
constexpr size_t WS_END = 568 * MiB;
constexpr size_t WS_Y = WS_H, WS_H2 = WS_CAT;
constexpr int HID_ROWS = 41216;

__device__ __forceinline__ int lane_id() { unsigned ones = ~0u; asm volatile("" : "+s"(ones)); return (int)__builtin_amdgcn_mbcnt_hi(ones, __builtin_amdgcn_mbcnt_lo(ones, 0u)); }
template <int S> __device__ __forceinline__ float swz_xor(float v) { return __int_as_float(__builtin_amdgcn_ds_swizzle(__float_as_int(v), (S << 10) | 0x1f)); }
__device__ __forceinline__ float half_sum(float v) { v += swz_xor<1>(v); v += swz_xor<2>(v); v += swz_xor<4>(v); v += swz_xor<8>(v); v += swz_xor<16>(v); return v; }
__device__ __forceinline__ float wave_sum(float v) { v = half_sum(v); auto rr = __builtin_amdgcn_permlane32_swap(__float_as_uint(v), __float_as_uint(v), false, false); return __uint_as_float(rr[0]) + __uint_as_float(rr[1]); }
typedef float cf32x2_t __attribute__((ext_vector_type(2))); typedef __bf16 cbf16x2_t __attribute__((ext_vector_type(2)));
__device__ __forceinline__ unsigned cvt2bf(float lo, float hi) { cf32x2_t v = {lo, hi}; cbf16x2_t b = __builtin_convertvector(v, cbf16x2_t); return __builtin_bit_cast(unsigned, b); }
__device__ __forceinline__ unsigned pk4_fp8(float a, float b, float cc, float d) { int w = __builtin_amdgcn_cvt_pk_fp8_f32(a, b, 0, false); w = __builtin_amdgcn_cvt_pk_fp8_f32(cc, d, w, true); return (unsigned)w; }
constexpr float F8_WSCALE = 32.f, F8_ASCALE = 8.f;
__device__ __forceinline__ float wave_max(float v) { v = fmaxf(v, swz_xor<1>(v)); v = fmaxf(v, swz_xor<2>(v)); v = fmaxf(v, swz_xor<4>(v)); v = fmaxf(v, swz_xor<8>(v)); v = fmaxf(v, swz_xor<16>(v));
    auto rr = __builtin_amdgcn_permlane32_swap(__float_as_uint(v), __float_as_uint(v), false, false); return fmaxf(__uint_as_float(rr[0]), __uint_as_float(rr[1])); }
__device__ __forceinline__ unsigned pk4_i8(float a, float b, float cc, float d, float qs) {
    const unsigned t0 = __float_as_uint(fmaf(a, qs, 12582912.f)), t1 = __float_as_uint(fmaf(b, qs, 12582912.f)), t2 = __float_as_uint(fmaf(cc, qs, 12582912.f)), t3 = __float_as_uint(fmaf(d, qs, 12582912.f));
    return __builtin_amdgcn_perm(__builtin_amdgcn_perm(t3, t2, 0x0c0c0400u), __builtin_amdgcn_perm(t1, t0, 0x0c0c0400u), 0x05040100u); }
constexpr float F8_YSCALE = 16.f;
namespace pg8 {
#define PG8_LAS __attribute__((address_space(3)))
typedef unsigned short bf16_t;
typedef short bf16x8 __attribute__((ext_vector_type(8)));
typedef float f32x4 __attribute__((ext_vector_type(4)));
typedef unsigned u32x4 __attribute__((ext_vector_type(4)));
typedef unsigned u32x2 __attribute__((ext_vector_type(2)));
constexpr int BM = 256, BK = 64, HALF = 128, HTB = HALF * BK * 2  , STAGE_BYTES = 8 * HTB, NXCD = 8, WGM = 8;

__host__ __device__ __forceinline__ int lds_byte(int r, int c) { const int st = (r >> 4) * 2 + (c >> 5), rr = r & 15, cc = c & 31, ob = rr * 64 + cc * 2; return st * 1024 + (ob ^ (((ob >> 9) & 1) << 5)); }
__host__ __device__ __forceinline__ void stage_rc(int b, int& R, int& C) { const int st = b / 1024, sb = b % 1024, swz = sb ^ (((sb >> 9) & 1) << 5); R = (st >> 1) * 16 + swz / 64; C = (st & 1) * 32 + (swz % 64) / 2; }
__host__ __device__ __forceinline__ int perm32(int rho) { const int n = rho >> 4, i = rho & 15; return 8 * (i >> 2) + 4 * n + (i & 3); }

struct Unit { int pm, pn, ui, e; };
struct Gemm { const bf16_t* A; const bf16_t* Bt; int M, N, K; };

struct StaticOrder {
    int nM, nN, nwg, G, c;
    __host__ __device__ void init(int M, int N, int G_, int c_) { nM = M / BM; nN = N / BM; nwg = nM * nN; G = G_; c = c_; }
    __host__ __device__ bool next(int i, Unit& u) const {
        const long L = (long)i * G + c; if (L >= nwg) return false;
        int wgid = (int)L; { const int q = nwg / NXCD, r = nwg % NXCD, xcd = wgid % NXCD, off = wgid / NXCD; wgid = (xcd < r ? xcd * (q + 1) : r * (q + 1) + (xcd - r) * q) + off; }
        const int nig = WGM * nN, gid = wgid / nig, fm = gid * WGM, gsz = (nM - fm) < WGM ? (nM - fm) : WGM;
        u.pm = fm + ((wgid % nig) % gsz); u.pn = (wgid % nig) / gsz; return true;
    }
    __device__ __forceinline__ void a_ready(const Unit&) const {}
    __device__ __forceinline__ void done(const Unit&) const {}
};

__device__ __forceinline__ unsigned cvt_pk_bf16(float lo, float hi) { unsigned r; asm volatile("v_cvt_pk_bf16_f32 %0, %1, %2" : "=v"(r) : "v"(lo), "v"(hi)); return r; }
typedef float f32x2 __attribute__((ext_vector_type(2)));
struct EpiProj {
    static constexpr bool PERM = true, AFTER_DRAIN = false;
    bf16_t* O; int ldc;
    __device__ __forceinline__ void operator()(const f32x4 (&acc)[2][2][4][2], const Unit& u, int wr, int wc, int fr, int fq) const {
        const int row0 = u.pm * BM + wr * 64 + fr, col0 = u.pn * BM + wc * 32 + 8 * fq;
        const float sc = (u.pn < 4) ? QA_SCALE : ((u.pn == 12 || u.pn == 13) ? QB_SCALE : 1.f);
#pragma unroll
        for (int ai = 0; ai < 2; ++ai)
#pragma unroll
            for (int m = 0; m < 4; ++m) { bf16_t* rowp = O + (size_t)(row0 + ai * HALF + m * 16) * ldc + col0;
#pragma unroll
                for (int bj = 0; bj < 2; ++bj) { const f32x4 v0 = acc[ai][bj][m][0] * sc, v1 = acc[ai][bj][m][1] * sc;
                    u32x4 w; w.x = cvt_pk_bf16(v0[0], v0[1]); w.y = cvt_pk_bf16(v0[2], v0[3]); w.z = cvt_pk_bf16(v1[0], v1[1]); w.w = cvt_pk_bf16(v1[2], v1[3]);
                    *(u32x4*)(rowp + bj * HALF) = w; } }
    }
};
struct EpiPlain {
    static constexpr bool PERM = true, AFTER_DRAIN = false;
    bf16_t* O; int ldc;
    __device__ __forceinline__ void operator()(const f32x4 (&acc)[2][2][4][2], const Unit& u, int wr, int wc, int fr, int fq) const {
        const int row0 = u.pm * BM + wr * 64 + fr, col0 = u.pn * BM + wc * 32 + 8 * fq;
#pragma unroll
        for (int ai = 0; ai < 2; ++ai)
#pragma unroll
            for (int m = 0; m < 4; ++m) { bf16_t* rowp = O + (size_t)(row0 + ai * HALF + m * 16) * ldc + col0;
#pragma unroll
                for (int bj = 0; bj < 2; ++bj) { const f32x4 v0 = acc[ai][bj][m][0], v1 = acc[ai][bj][m][1];
                    u32x4 w; w.x = cvt_pk_bf16(v0[0], v0[1]); w.y = cvt_pk_bf16(v0[2], v0[3]); w.z = cvt_pk_bf16(v1[0], v1[1]); w.w = cvt_pk_bf16(v1[2], v1[3]);
                    *(u32x4*)(rowp + bj * HALF) = w; } }
    }
};
template <class Epi, class Sched, bool ALIGN_EPI = false, bool SP2 = false>
__device__ __forceinline__ void gemm_phase(PG8_LAS unsigned char* lds, const Gemm g, const Sched& S, const Epi& E, int wave_id) {
    const int wid = wave_id, lane = lane_id(), tid = wid * 64 + lane, wr = wid >> 2, wc = wid & 3, fr = lane & 15, fq = lane >> 4;
    const int K = g.K, nt = K / BK;
    unsigned voffA[2], voffB[2];
#pragma unroll
    for (int i = 0; i < 2; ++i) { int R, C; stage_rc(tid * 16 + i * 8192, R, C); const int Rb = Epi::PERM ? ((R & ~31) + perm32(R & 31)) : R;
        voffA[i] = (unsigned)(R * K + C) * 2u; voffB[i] = (unsigned)(Rb * K + C) * 2u; }
    const size_t kstep = (size_t)(BK * 2);
    const size_t hstep = (size_t)HALF * K * 2;
    const size_t tstep = 2 * hstep;
    const unsigned ldsw = (unsigned)wid * 1024u;
    const int aoff = lds_byte(wr * 64 + fr, fq * 8), boff = lds_byte(wc * 32 + fr, fq * 8);
#define PG8_SA(b, h) (((b) * 2 + (h)) * HTB)
#define PG8_SB(b, h) ((4 + (b) * 2 + (h)) * HTB)
#define PG8_STAGE(bufoff, gbase, voff) do { _Pragma("unroll") for (int _i = 0; _i < 2; ++_i) \
        __builtin_amdgcn_global_load_lds((const unsigned*)((const char*)(gbase) + (voff)[_i]), (PG8_LAS unsigned*)(lds + (bufoff) + ldsw + _i * 8192), 16, 0, 0); } while (0)
#define PG8_LDA(dst, b, h) do { _Pragma("unroll") for (int m = 0; m < 4; ++m) _Pragma("unroll") for (int k = 0; k < 2; ++k) dst[m][k] = *(const PG8_LAS bf16x8*)(lds + PG8_SA(b, h) + aoff + m * 2048 + k * 1024); } while (0)
#define PG8_LDB(dst, b, h) do { _Pragma("unroll") for (int n = 0; n < 2; ++n) _Pragma("unroll") for (int k = 0; k < 2; ++k) dst[n][k] = *(const PG8_LAS bf16x8*)(lds + PG8_SB(b, h) + boff + n * 2048 + k * 1024); } while (0)
#define PG8_MMA(ai, bj, At, Bt) do { __builtin_amdgcn_s_setprio(1); _Pragma("unroll") for (int m = 0; m < 4; ++m) _Pragma("unroll") for (int n = 0; n < 2; ++n) _Pragma("unroll") for (int k = 0; k < 2; ++k) \
        acc[ai][bj][m][n] = __builtin_amdgcn_mfma_f32_16x16x32_bf16(Bt[n][k], At[m][k], acc[ai][bj][m][n], 0, 0, 0); __builtin_amdgcn_s_setprio(0); } while (0)
#define PG8_WAIT_V(n) asm volatile("s_waitcnt vmcnt(" #n ")" ::: "memory")
#define PG8_WAIT_L(n) asm volatile("s_waitcnt lgkmcnt(" #n ")" ::: "memory")
#define PG8_BAR __builtin_amdgcn_s_barrier()
#define PG8_SCHED __builtin_amdgcn_sched_barrier(0)
    Unit cur, nxt; int ui = 0;
    if (!S.next(0, cur)) return;
    f32x4 acc[2][2][4][2];
#pragma unroll
    for (int a = 0; a < 2; ++a)
#pragma unroll
        for (int b = 0; b < 2; ++b)
#pragma unroll
            for (int m = 0; m < 4; ++m)
#pragma unroll
                for (int n = 0; n < 2; ++n) acc[a][b][m][n] = (f32x4){0.f, 0.f, 0.f, 0.f};
    bf16x8 At[4][2], B0[2][2], B1[2][2];
    const char* cA = (const char*)g.A + (size_t)cur.pm * tstep; const char* cB = (const char*)g.Bt + (size_t)cur.pn * tstep;
    S.a_ready(cur);
    if constexpr (SP2) {
        PG8_STAGE(PG8_SB(0, 0), cB, voffB); PG8_STAGE(PG8_SB(0, 1), cB + hstep, voffB); PG8_STAGE(PG8_SA(0, 0), cA, voffA); PG8_STAGE(PG8_SA(0, 1), cA + hstep, voffA);
        if (wr == 1) PG8_BAR;
        PG8_WAIT_V(2); PG8_BAR;
        PG8_STAGE(PG8_SB(1, 0), cB + kstep, voffB); PG8_STAGE(PG8_SA(1, 0), cA + kstep, voffA); PG8_STAGE(PG8_SB(1, 1), cB + hstep + kstep, voffB);
        PG8_WAIT_V(6); PG8_BAR;
    } else {
        PG8_STAGE(PG8_SB(0, 0), cB, voffB); PG8_STAGE(PG8_SA(0, 0), cA, voffA); PG8_STAGE(PG8_SB(0, 1), cB + hstep, voffB); PG8_STAGE(PG8_SA(0, 1), cA + hstep, voffA);
        if (wr == 1) PG8_BAR;
        PG8_WAIT_V(4); PG8_BAR;
        PG8_STAGE(PG8_SB(1, 0), cB + kstep, voffB); PG8_STAGE(PG8_SA(1, 0), cA + kstep, voffA); PG8_STAGE(PG8_SB(1, 1), cB + hstep + kstep, voffB);
        PG8_WAIT_V(6); PG8_BAR;
    }
    for (;;) {
        const bool has_next = S.next(ui + 1, nxt);
        const char* nA = has_next ? (const char*)g.A + (size_t)nxt.pm * tstep : cA; const char* nB = has_next ? (const char*)g.Bt + (size_t)nxt.pn * tstep : cB;
        for (int t = 0; t < nt; t += 2) {
            const bool last = (t == nt - 2);
            const char* a1 = cA + (size_t)(t + 1) * kstep;
            const char* a2 = last ? nA : cA + (size_t)(t + 2) * kstep; const char* b2 = last ? nB : cB + (size_t)(t + 2) * kstep;
            const char* a3 = a2 + kstep; const char* b3 = b2 + kstep;
            if (last && has_next) S.a_ready(nxt);
            if constexpr (SP2) {
            PG8_LDB(B0, 0, 0); PG8_LDB(B1, 0, 1); PG8_SCHED; PG8_LDA(At, 0, 0); PG8_STAGE(PG8_SA(1, 1), a1 + hstep, voffA);
            PG8_WAIT_V(8); PG8_WAIT_L(0); PG8_BAR; PG8_MMA(0, 0, At, B0); PG8_MMA(0, 1, At, B1); PG8_BAR; PG8_SCHED;
            PG8_LDA(At, 0, 1); PG8_STAGE(PG8_SB(0, 0), b2, voffB); PG8_STAGE(PG8_SB(0, 1), b2 + hstep, voffB); PG8_STAGE(PG8_SA(0, 0), a2, voffA);
            PG8_WAIT_V(8); PG8_WAIT_L(0); PG8_BAR; PG8_MMA(1, 0, At, B0); PG8_MMA(1, 1, At, B1); PG8_BAR; PG8_SCHED;
            PG8_LDB(B0, 1, 0); PG8_LDB(B1, 1, 1); PG8_SCHED; PG8_LDA(At, 1, 0); PG8_STAGE(PG8_SA(0, 1), a2 + hstep, voffA);
            PG8_WAIT_V(8); PG8_WAIT_L(0); PG8_BAR; PG8_MMA(0, 0, At, B0); PG8_MMA(0, 1, At, B1); PG8_BAR; PG8_SCHED;
            PG8_LDA(At, 1, 1); PG8_STAGE(PG8_SB(1, 0), b3, voffB); PG8_STAGE(PG8_SB(1, 1), b3 + hstep, voffB); PG8_STAGE(PG8_SA(1, 0), a3, voffA);
            PG8_WAIT_V(8); PG8_WAIT_L(0); PG8_BAR; PG8_MMA(1, 0, At, B0); PG8_MMA(1, 1, At, B1); PG8_BAR; PG8_SCHED;
            } else {
            PG8_LDB(B0, 0, 0); PG8_SCHED; PG8_LDA(At, 0, 0); PG8_STAGE(PG8_SA(1, 1), a1 + hstep, voffA);
            PG8_WAIT_L(8); PG8_BAR; PG8_WAIT_L(0); PG8_MMA(0, 0, At, B0); PG8_BAR; PG8_SCHED;
            PG8_LDB(B1, 0, 1); PG8_STAGE(PG8_SB(0, 0), b2, voffB);
            PG8_BAR; PG8_WAIT_L(0); PG8_MMA(0, 1, At, B1); PG8_BAR;
            PG8_LDA(At, 0, 1); PG8_STAGE(PG8_SA(0, 0), a2, voffA);
            PG8_BAR; PG8_WAIT_L(0); PG8_MMA(1, 0, At, B0); PG8_BAR; PG8_SCHED;
            PG8_STAGE(PG8_SB(0, 1), b2 + hstep, voffB);
            PG8_WAIT_V(6); PG8_BAR; PG8_MMA(1, 1, At, B1); PG8_BAR;
            PG8_LDB(B0, 1, 0); PG8_SCHED; PG8_LDA(At, 1, 0); PG8_STAGE(PG8_SA(0, 1), a2 + hstep, voffA);
            PG8_WAIT_L(8); PG8_BAR; PG8_WAIT_L(0); PG8_MMA(0, 0, At, B0); PG8_BAR; PG8_SCHED;
            PG8_LDB(B1, 1, 1); PG8_STAGE(PG8_SB(1, 0), b3, voffB);
            PG8_BAR; PG8_WAIT_L(0); PG8_MMA(0, 1, At, B1); PG8_BAR;
            PG8_LDA(At, 1, 1); PG8_STAGE(PG8_SA(1, 0), a3, voffA);
            PG8_BAR; PG8_WAIT_L(0); PG8_MMA(1, 0, At, B0); PG8_BAR; PG8_SCHED;
            PG8_STAGE(PG8_SB(1, 1), b3 + hstep, voffB);
            PG8_WAIT_V(6); PG8_BAR; PG8_MMA(1, 1, At, B1); PG8_BAR;
            }
        }
        if constexpr (ALIGN_EPI) { if (wr == 0) PG8_BAR; }
        if constexpr (!Epi::AFTER_DRAIN) { E(acc, cur, wr, wc, fr, fq); S.done(cur); }
        if (!has_next) break;
#pragma unroll
        for (int a = 0; a < 2; ++a)
#pragma unroll
            for (int b = 0; b < 2; ++b)
#pragma unroll
                for (int m = 0; m < 4; ++m)
#pragma unroll
                    for (int n = 0; n < 2; ++n) acc[a][b][m][n] = (f32x4){0.f, 0.f, 0.f, 0.f};
        cur = nxt; cA = nA; cB = nB; ++ui;
        if constexpr (ALIGN_EPI) { if (wr == 1) PG8_BAR; }
    }
    PG8_WAIT_V(0);
    if constexpr (!ALIGN_EPI) { if (wr == 0) PG8_BAR; }
    PG8_BAR;
    if constexpr (Epi::AFTER_DRAIN) { E.fused(acc, cur, wr, wc, fr, fq, lds, wid, lane); S.done(cur); }
#undef PG8_SA
#undef PG8_SB
#undef PG8_STAGE
#undef PG8_LDA
#undef PG8_LDB
#undef PG8_MMA
#undef PG8_WAIT_V
#undef PG8_WAIT_L
#undef PG8_BAR
#undef PG8_SCHED
}

__device__ __forceinline__ void glds16s(const void* sbase, unsigned voff, unsigned lds_dst) {
    asm volatile("s_mov_b32 m0, %2\n\ts_nop 0\n\tglobal_load_lds_dwordx4 %0, %1" :: "v"(voff), "s"(sbase), "s"(lds_dst) : "memory"); }
template <class Epi, class Sched, int MODE = 0>
__device__ __forceinline__ void gemm_phase_g(PG8_LAS unsigned char* lds, const Gemm g, const Sched& S, const Epi& E, int wave_id) {
    constexpr bool F8 = (MODE == 1);
    const int wid = wave_id, lane = lane_id(), tid = wid * 64 + lane, wr = wid >> 2, wc = wid & 3, fr = lane & 15, fq = lane >> 4;
    const int K = g.K, nt = K / BK;
    unsigned voffB[2];
#pragma unroll
    for (int i = 0; i < 2; ++i) { int R, C; stage_rc(tid * 16 + i * 8192, R, C); const int Rb = Epi::PERM ? ((R & ~31) + perm32(R & 31)) : R; voffB[i] = (unsigned)(Rb * K + C) * 2u; }
#define PG8_AOFFS(u, dst) do { int Rr_[2], Cc_[2]; const int t_ = wid * 64 + lane_id(); _Pragma("unroll") for (int i = 0; i < 2; ++i) stage_rc(t_ * 16 + i * 8192, Rr_[i], Cc_[i]); S.a_offs(g, u, Rr_, Cc_, dst); } while (0)
    const size_t kstep = (size_t)(BK * 2);
    const size_t hstep = (size_t)HALF * K * 2;
    const unsigned ldsu = (unsigned)__builtin_amdgcn_readfirstlane((int)((unsigned)(uintptr_t)lds + (unsigned)wid * 1024u));
    const int aoff = lds_byte(wr * 64 + fr, fq * (F8 ? 16 : 8)), boff = lds_byte(wc * 32 + fr, fq * (F8 ? 16 : 8));
    constexpr int KOFF = F8 ? 16 : 1024;
    int abase8 = (int)(unsigned)(uintptr_t)lds + aoff, bbase8 = (int)(unsigned)(uintptr_t)lds + 65536 + boff;
    asm volatile("" : "+v"(abase8), "+v"(bbase8));
#define PG8_SA(b, h) (((b) * 2 + (h)) * HTB)
#define PG8_SB(b, h) ((4 + (b) * 2 + (h)) * HTB)
#define PG8_STAGE(bufoff, gbase, voff) do { _Pragma("unroll") for (int _i = 0; _i < 2; ++_i) \
        glds16s((const void*)(gbase), (voff)[_i], ldsu + (unsigned)((bufoff) + _i * 8192)); } while (0)
#define PG8_LDA(dst, b, h) do { if constexpr (F8) { _Pragma("unroll") for (int m = 0; m < 4; ++m) dst##8[m] = *(const PG8_LAS v8i_t*)(unsigned)(abase8 + PG8_SA(b, h) + m * 2048); } \
        else { _Pragma("unroll") for (int m = 0; m < 4; ++m) _Pragma("unroll") for (int k = 0; k < 2; ++k) dst[m][k] = *(const PG8_LAS bf16x8*)(lds + PG8_SA(b, h) + aoff + m * 2048 + k * KOFF); } } while (0)
#define PG8_LDB(dst, b, h) do { if constexpr (F8) { _Pragma("unroll") for (int n = 0; n < 2; ++n) dst##8[n] = *(const PG8_LAS v8i_t*)(unsigned)(bbase8 + (PG8_SB(b, h) - 65536) + n * 2048); } \
        else { _Pragma("unroll") for (int n = 0; n < 2; ++n) _Pragma("unroll") for (int k = 0; k < 2; ++k) dst[n][k] = *(const PG8_LAS bf16x8*)(lds + PG8_SB(b, h) + boff + n * 2048 + k * KOFF); } } while (0)
#define PG8_MMA(ai, bj, At, Bt) do { __builtin_amdgcn_s_setprio(1); \
        if constexpr (F8) { _Pragma("unroll") for (int m = 0; m < 4; ++m) _Pragma("unroll") for (int n = 0; n < 2; ++n) \
            acc[ai][bj][m][n] = __builtin_amdgcn_mfma_scale_f32_16x16x128_f8f6f4(Bt##8[n], At##8[m], acc[ai][bj][m][n], 0, 0, 0, 0x7f7f7f7f, 0, 0x7f7f7f7f); } \
        else if constexpr (MODE == 2) { _Pragma("unroll") for (int m = 0; m < 4; ++m) _Pragma("unroll") for (int n = 0; n < 2; ++n) _Pragma("unroll") for (int k = 0; k < 2; ++k) \
            acc[ai][bj][m][n] = __builtin_bit_cast(f32x4, __builtin_amdgcn_mfma_i32_16x16x64_i8(__builtin_bit_cast(v4i_t, Bt[n][k]), __builtin_bit_cast(v4i_t, At[m][k]), __builtin_bit_cast(v4i_t, acc[ai][bj][m][n]), 0, 0, 0)); } \
        else { _Pragma("unroll") for (int m = 0; m < 4; ++m) _Pragma("unroll") for (int n = 0; n < 2; ++n) _Pragma("unroll") for (int k = 0; k < 2; ++k) \
            acc[ai][bj][m][n] = __builtin_amdgcn_mfma_f32_16x16x32_bf16(Bt[n][k], At[m][k], acc[ai][bj][m][n], 0, 0, 0); } \
        __builtin_amdgcn_s_setprio(0); } while (0)
#define PG8_WAIT_V(n) asm volatile("s_waitcnt vmcnt(" #n ")" ::: "memory")
#define PG8_WAIT_L(n) asm volatile("s_waitcnt lgkmcnt(" #n ")" ::: "memory")
#define PG8_BAR __builtin_amdgcn_s_barrier()
#define PG8_SCHED __builtin_amdgcn_sched_barrier(0)
    Unit cur, nxt; int ui = 0;
    if (!S.next(0, cur)) return;
    f32x4 acc[2][2][4][2];
#pragma unroll
    for (int a = 0; a < 2; ++a)
#pragma unroll
        for (int b = 0; b < 2; ++b)
#pragma unroll
            for (int m = 0; m < 4; ++m)
#pragma unroll
                for (int n = 0; n < 2; ++n) acc[a][b][m][n] = (f32x4){0.f, 0.f, 0.f, 0.f};
    typedef int v8i_t __attribute__((ext_vector_type(8))); typedef int v4i_t __attribute__((ext_vector_type(4)));
    bf16x8 At[4][2], B0[2][2], B1[2][2];
    v8i_t At8[4], B08[2], B18[2];
    unsigned va[2][2];
    PG8_AOFFS(cur, va);
    const char* const Ab = (const char*)g.A; const char* cB = S.b_base(g, cur);
    PG8_STAGE(PG8_SB(0, 0), cB, voffB); PG8_STAGE(PG8_SB(0, 1), cB + hstep, voffB); PG8_STAGE(PG8_SA(0, 0), Ab, va[0]); PG8_STAGE(PG8_SA(0, 1), Ab, va[1]);
    if (wr == 1) PG8_BAR;
    PG8_WAIT_V(2); PG8_BAR;
    PG8_STAGE(PG8_SB(1, 0), cB + kstep, voffB); PG8_STAGE(PG8_SA(1, 0), Ab + kstep, va[0]); PG8_STAGE(PG8_SB(1, 1), cB + hstep + kstep, voffB);
    PG8_WAIT_V(6); PG8_BAR;
    for (;;) {
        const bool has_next = S.next(ui + 1, nxt);
        const char* nB = cB;
        if (has_next) nB = S.b_base(g, nxt);
#pragma unroll 1
        for (int t = 0; t < nt; t += 2) {
            const bool last = (t == nt - 2);
            const char* a1 = Ab + (size_t)(t + 1) * kstep;
            const size_t k2 = last ? (size_t)0 : (size_t)(t + 2) * kstep;
            const char* a2 = Ab + k2; const char* b2 = (last ? nB : cB) + k2;
            const char* a3 = a2 + kstep; const char* b3 = b2 + kstep;
            PG8_LDB(B0, 0, 0); PG8_LDB(B1, 0, 1); PG8_SCHED; PG8_LDA(At, 0, 0); PG8_STAGE(PG8_SA(1, 1), a1, va[1]);
            if (last && has_next) PG8_AOFFS(nxt, va);
            PG8_WAIT_V(8); PG8_WAIT_L(0); PG8_BAR; PG8_MMA(0, 0, At, B0); PG8_MMA(0, 1, At, B1); PG8_BAR; PG8_SCHED;
            PG8_LDA(At, 0, 1); PG8_STAGE(PG8_SB(0, 0), b2, voffB); PG8_STAGE(PG8_SB(0, 1), b2 + hstep, voffB); PG8_STAGE(PG8_SA(0, 0), a2, va[0]);
            PG8_WAIT_V(8); PG8_WAIT_L(0); PG8_BAR; PG8_MMA(1, 0, At, B0); PG8_MMA(1, 1, At, B1); PG8_BAR; PG8_SCHED;
            PG8_LDB(B0, 1, 0); PG8_LDB(B1, 1, 1); PG8_SCHED; PG8_LDA(At, 1, 0); PG8_STAGE(PG8_SA(0, 1), a2, va[1]);
            PG8_WAIT_V(8); PG8_WAIT_L(0); PG8_BAR; PG8_MMA(0, 0, At, B0); PG8_MMA(0, 1, At, B1); PG8_BAR; PG8_SCHED;
            PG8_LDA(At, 1, 1); PG8_STAGE(PG8_SB(1, 0), b3, voffB); PG8_STAGE(PG8_SB(1, 1), b3 + hstep, voffB); PG8_STAGE(PG8_SA(1, 0), a3, va[0]);
            PG8_WAIT_V(8); PG8_WAIT_L(0); PG8_BAR; PG8_MMA(1, 0, At, B0); PG8_MMA(1, 1, At, B1); PG8_BAR; PG8_SCHED;
        }
        if (wr == 0) PG8_BAR;
        E(acc, cur, wr, wc, fr, fq);
        if (!has_next) break;
#pragma unroll
        for (int a = 0; a < 2; ++a)
#pragma unroll
            for (int b = 0; b < 2; ++b)
#pragma unroll
                for (int m = 0; m < 4; ++m)
#pragma unroll
                    for (int n = 0; n < 2; ++n) acc[a][b][m][n] = (f32x4){0.f, 0.f, 0.f, 0.f};
        cur = nxt; cB = nB; ++ui;
        if (wr == 1) PG8_BAR;
    }
    PG8_WAIT_V(0);
    PG8_BAR;
#undef PG8_SA
#undef PG8_SB
#undef PG8_STAGE
#undef PG8_LDA
#undef PG8_LDB
#undef PG8_MMA
#undef PG8_WAIT_V
#undef PG8_WAIT_L
#undef PG8_BAR
#undef PG8_SCHED
#undef PG8_AOFFS
}

constexpr int MOE_MAXU = 6;
__device__ __forceinline__ bool moe_unit(const PG8_LAS unsigned* tstart, int NJ, int G, int c, int i, int& tt, int& pn, int& e) {
    if (i >= MOE_MAXU) return false;
    if (tstart[33] != 0u) { const int x = c & 7, s = c >> 3, t0 = (int)tstart[4 * x], t1 = (int)tstart[4 * x + 4], q = i * (G >> 3) + s; if (q >= (t1 - t0) * NJ) return false; tt = t0 + q / NJ; pn = q % NJ; }
    else { const int L = i * G + c; if (L >= (int)tstart[32] * NJ) return false; tt = L / NJ; pn = L % NJ; }
    const int l = lane_id();
    const bool le = (l >= 1 && l < 32) ? ((int)tstart[l & 31] <= tt) : false;
    e = __builtin_popcountll(__ballot(le)); return true;
}
struct MoeOrder {
    const PG8_LAS unsigned* tstart; const PG8_LAS unsigned* rowmap; int NJ, G, c; bool gather; size_t b_estride;
    __device__ __forceinline__ bool next(int i, Unit& u) const {
        int tt, pn, e; const bool ok = moe_unit(tstart, NJ, G, c, i, tt, pn, e);
        if (!__builtin_amdgcn_readfirstlane((int)ok)) return false;
        u.pm = __builtin_amdgcn_readfirstlane(tt); u.pn = __builtin_amdgcn_readfirstlane(pn); u.ui = i; u.e = __builtin_amdgcn_readfirstlane(e); return true;
    }
    __device__ __forceinline__ void a_offs(const Gemm& g, const Unit& u, const int (&R)[2], const int (&C)[2], unsigned (&va)[2][2]) const {
#pragma unroll
        for (int h = 0; h < 2; ++h)
#pragma unroll
            for (int i = 0; i < 2; ++i) { const unsigned row = gather ? rowmap[u.ui * 256 + h * 128 + R[i]] : (unsigned)(u.pm * 256 + h * 128 + R[i]); va[h][i] = (row * (unsigned)g.K + (unsigned)C[i]) * 2u; }
    }
    __device__ __forceinline__ const char* b_base(const Gemm& g, const Unit& u) const { return (const char*)g.Bt + (size_t)u.e * b_estride + (size_t)u.pn * 256 * g.K * 2; }
};
struct EpiUp {
    static constexpr bool PERM = true, AFTER_DRAIN = false;
    unsigned char* HID; const PG8_LAS float* cwt;
    __device__ __forceinline__ void operator()(const f32x4 (&acc)[2][2][4][2], const Unit& u, int wr, int wc, int fr, int fq) const {
        const int col0 = u.pn * HALF + wc * 32 + 8 * fq;
#pragma unroll
        for (int ai = 0; ai < 2; ++ai)
#pragma unroll
            for (int m = 0; m < 4; ++m) { const int r = ai * HALF + wr * 64 + m * 16 + fr; const float cws = cwt[u.ui * 256 + r] * (F8_ASCALE / F8_WSCALE);
                float o[8];
#pragma unroll
                for (int n = 0; n < 2; ++n)
#pragma unroll
                    for (int j = 0; j < 4; ++j) { const float a = acc[ai][0][m][n][j] * (1.f / F8_WSCALE), b = acc[ai][1][m][n][j]; o[4 * n + j] = a * __builtin_amdgcn_rcpf(1.f + __builtin_amdgcn_exp2f(-1.4426950408889634f * a)) * b * cws; }
                u32x2 w; w.x = pk4_fp8(o[0], o[1], o[2], o[3]); w.y = pk4_fp8(o[4], o[5], o[6], o[7]);
                *(u32x2*)(HID + (unsigned)((u.pm * 256 + r) * 512 + col0)) = w; }
    }
};
struct EpiDown {
    static constexpr bool PERM = true, AFTER_DRAIN = false;
    unsigned char* Y2; const PG8_LAS unsigned* rowmap;
    __device__ __forceinline__ void operator()(const f32x4 (&acc)[2][2][4][2], const Unit& u, int wr, int wc, int fr, int fq) const {
        const int col0 = u.pn * BM + wc * 32 + 8 * fq;
#pragma unroll
        for (int ai = 0; ai < 2; ++ai)
#pragma unroll
            for (int m = 0; m < 4; ++m) { const int r = ai * HALF + wr * 64 + m * 16 + fr; const unsigned tg = rowmap[u.ui * 256 + r];
                if (tg != 0xffffffffu) { unsigned char* rowp = Y2 + (unsigned)(tg * 2048u + (unsigned)col0);
#pragma unroll
                    for (int bj = 0; bj < 2; ++bj) { const f32x4 v0 = acc[ai][bj][m][0] * (F8_YSCALE / (F8_WSCALE * F8_ASCALE)), v1 = acc[ai][bj][m][1] * (F8_YSCALE / (F8_WSCALE * F8_ASCALE));
                        u32x2 w; w.x = pk4_fp8(v0[0], v0[1], v0[2], v0[3]); w.y = pk4_fp8(v1[0], v1[1], v1[2], v1[3]);
                        *(u32x2*)(rowp + bj * HALF) = w; } } }
    }
};
struct StaticOrderG : StaticOrder {
    __device__ __forceinline__ bool next(int i, Unit& u) const { if (!StaticOrder::next(i, u)) return false; u.ui = i; u.e = 0; return true; }
    __device__ __forceinline__ void a_offs(const Gemm& g, const Unit& u, const int (&R)[2], const int (&C)[2], unsigned (&va)[2][2]) const {
#pragma unroll
        for (int h = 0; h < 2; ++h)
#pragma unroll
            for (int i = 0; i < 2; ++i) va[h][i] = ((unsigned)(u.pm * 256 + h * 128 + R[i]) * (unsigned)g.K + (unsigned)C[i]) * 2u;
    }
    __device__ __forceinline__ const char* b_base(const Gemm& g, const Unit& u) const { return (const char*)g.Bt + (size_t)u.pn * 256 * g.K * 2; }
};
struct EpiProjQ {
    static constexpr bool PERM = true, AFTER_DRAIN = false;
    bf16_t* O; int ldc; const float* rs; const unsigned* cmax;
    __device__ __forceinline__ void operator()(const f32x4 (&acc)[2][2][4][2], const Unit& u, int wr, int wc, int fr, int fq) const {
        const int row0 = u.pm * BM + wr * 64 + fr, col0 = u.pn * BM + wc * 32 + 8 * fq;
        const float sc = ((u.pn < 4) ? QA_SCALE : ((u.pn == 12 || u.pn == 13) ? QB_SCALE : 1.f)) * (1.f / 127.f);
        float cs[2][8];
#pragma unroll
        for (int bj = 0; bj < 2; ++bj) { const u32x4 c0 = *(const u32x4*)(cmax + col0 + bj * HALF), c1 = *(const u32x4*)(cmax + col0 + bj * HALF + 4);
#pragma unroll
            for (int j = 0; j < 4; ++j) { cs[bj][j] = __uint_as_float(c0[j]) * sc; cs[bj][4 + j] = __uint_as_float(c1[j]) * sc; } }
        float rr[2][4];
#pragma unroll
        for (int ai = 0; ai < 2; ++ai)
#pragma unroll
            for (int m = 0; m < 4; ++m) rr[ai][m] = rs[row0 + ai * HALF + m * 16];
#pragma unroll
        for (int ai = 0; ai < 2; ++ai)
#pragma unroll
            for (int m = 0; m < 4; ++m) { const int row = row0 + ai * HALF + m * 16; const float r = rr[ai][m]; bf16_t* rowp = O + (size_t)row * ldc + col0;
#pragma unroll
                for (int bj = 0; bj < 2; ++bj) { float v[8];
#pragma unroll
                    for (int j = 0; j < 4; ++j) { v[j] = (float)(int)__float_as_uint(acc[ai][bj][m][0][j]) * r * cs[bj][j]; v[4 + j] = (float)(int)__float_as_uint(acc[ai][bj][m][1][j]) * r * cs[bj][4 + j]; }
                    u32x4 w; w.x = cvt_pk_bf16(v[0], v[1]); w.y = cvt_pk_bf16(v[2], v[3]); w.z = cvt_pk_bf16(v[4], v[5]); w.w = cvt_pk_bf16(v[6], v[7]);
                    *(u32x4*)(rowp + bj * HALF) = w; } }
    }
};
}
#define GAS __attribute__((address_space(1)))
#define LAS __attribute__((address_space(3)))
typedef unsigned short bf16;
typedef unsigned v4u __attribute__((ext_vector_type(4)));
typedef float f32x4 __attribute__((ext_vector_type(4)));
typedef short bf16x8 __attribute__((ext_vector_type(8)));
typedef GAS unsigned gu32;
typedef GAS unsigned long long gu64;
#define RLX_AGENT __ATOMIC_RELAXED, __HIP_MEMORY_SCOPE_AGENT
#define LDS_WAIT() asm volatile("s_waitcnt lgkmcnt(0)" ::: "memory")
#define VM_WAIT() asm volatile("s_waitcnt vmcnt(0)" ::: "memory")
__device__ __forceinline__ unsigned long long rt() { return __builtin_amdgcn_s_memrealtime(); }
__device__ __forceinline__ unsigned f2bf(float f) { unsigned u = __builtin_bit_cast(unsigned, f); return (u + 0x7fffu + ((u >> 16) & 1u)) >> 16; }
__device__ __forceinline__ unsigned pk2(float lo, float hi) { return f2bf(lo) | (f2bf(hi) << 16); }

#define XB_TMO      128
#define XB_XCNT(j)  (256  + 64 * (j))
#define XB_XSUB(j)  (1280 + 64 * (j))
#define XB_XGEN(j)  (2304 + 64 * (j))
#define XB_TOP      3328
#define XB_TOPGEN   3392
#define XCD_BAR_WORDS 3456
#define XB_SPIN_CAP (1u << 18)

__device__ __forceinline__ unsigned xb_ld(unsigned* p)              { return __hip_atomic_load(p, __ATOMIC_RELAXED, __HIP_MEMORY_SCOPE_AGENT); }
__device__ __forceinline__ unsigned xb_add(unsigned* p, unsigned v) { return __hip_atomic_fetch_add(p, v, __ATOMIC_RELAXED, __HIP_MEMORY_SCOPE_AGENT); }
__device__ __forceinline__ unsigned xb_xcc_id() { return (unsigned)__builtin_amdgcn_s_getreg((3 << 11) | 20) & 0xFu; }
#define XB_SPIN(cond, bar) do { unsigned _sp = 0; while (cond) { __builtin_amdgcn_s_sleep(4); \
    if ((++_sp & 255u) == 0u) { if (xb_ld(&(bar)[XB_TMO])) break; if (_sp > XB_SPIN_CAP) { atomicAdd(&(bar)[XB_TMO], 1u); break; } } } } while (0)

struct XcdBarrier {
    unsigned* bar; unsigned x;
    volatile LAS unsigned* st;
};

__device__ __forceinline__ XcdBarrier xcd_barrier_post(unsigned* bar, volatile LAS unsigned* st, bool leader_thread) {
    XcdBarrier b; b.bar = bar; b.x = xb_xcc_id(); b.st = st;
    if (leader_thread) (void)xb_add(&bar[XB_XCNT(b.x)], 1u);
    return b;
}
__device__ __forceinline__ void xcd_barrier_complete(unsigned* bar, unsigned x, unsigned& nloc, unsigned& nx) {
    const unsigned G = gridDim.x * gridDim.y * gridDim.z;
    unsigned sum, cnt, mine, sp = 0u;
    for (;;) {
        sum = 0u; cnt = 0u; mine = 0u;
#pragma unroll
        for (unsigned j = 0; j < 16; ++j) { const unsigned c = xb_ld(&bar[XB_XCNT(j)]); sum += c; cnt += (c > 0u) ? 1u : 0u; mine = (j == x) ? c : mine; }
        if (sum == G) break;
        __builtin_amdgcn_s_sleep(1);
        if ((++sp & 255u) == 0u) { if (xb_ld(&bar[XB_TMO])) break; if (sp > XB_SPIN_CAP) { atomicAdd(&bar[XB_TMO], 1u); break; } }
    }
    nloc = mine > 0u ? mine : 1u; nx = cnt > 0u ? cnt : 1u;
}

__device__ __forceinline__ void xcd_barrier(const XcdBarrier& b, bool leader_thread) {
    asm volatile("s_waitcnt vmcnt(0)" ::: "memory");
    __syncthreads();
    if (leader_thread) {
        unsigned* bar = b.bar;
        __builtin_amdgcn_s_waitcnt(0);
        unsigned nloc = b.st[0], nx = b.st[1];
        if (nloc == 0u) { xcd_barrier_complete(bar, b.x, nloc, nx); b.st[0] = nloc; b.st[1] = nx; }
        const unsigned old = xb_add(&bar[XB_XSUB(b.x)], 1u);
        const unsigned gen = old / nloc;
        if (old + 1u == (gen + 1u) * nloc) {
            __builtin_amdgcn_fence(__ATOMIC_RELEASE, "agent");
            asm volatile("s_waitcnt vmcnt(0)" ::: "memory");
            const unsigned og = xb_add(&bar[XB_TOP], 1u);
            const unsigned tg = og / nx;
            if (og + 1u == (tg + 1u) * nx) xb_add(&bar[XB_TOPGEN], 1u);
            else XB_SPIN(xb_ld(&bar[XB_TOPGEN]) == tg, bar);
            __builtin_amdgcn_fence(__ATOMIC_ACQUIRE, "agent");
            xb_add(&bar[XB_XGEN(b.x)], 1u);
            asm volatile("s_waitcnt vmcnt(0)" ::: "memory");
        } else {
            XB_SPIN(xb_ld(&bar[XB_XGEN(b.x)]) == gen, bar);
            __builtin_amdgcn_fence(__ATOMIC_ACQUIRE, "agent");
            asm volatile("s_waitcnt vmcnt(0)" ::: "memory");
        }
    }
    __syncthreads();
}
typedef unsigned u32x4 __attribute__((ext_vector_type(4)));
__device__ __forceinline__ float bf2f(unsigned b) { return __uint_as_float(b << 16); }
__device__ __forceinline__ float siluf(float x) { return x / (1.f + __expf(-x)); }
__device__ __forceinline__ float ada_get(const float* part, const float* b_ada, int b, int j) {
    float s = b_ada[j];
#pragma unroll
    for (int kq = 0; kq < 4; ++kq) s += part[(size_t)(kq * 4 + b) * NADA + j];
    return s;
}
__device__ __forceinline__ f32x4 ada_get4(const float* part, const float* b_ada, int b, int j) {
    f32x4 s = *(const f32x4*)(b_ada + j);
#pragma unroll
    for (int kq = 0; kq < 4; ++kq) s += *(const f32x4*)(part + (size_t)(kq * 4 + b) * NADA + j);
    return s;
}
__device__ __forceinline__ int t5_bucket(int rel) {
    const int n = rel < 0 ? -rel : rel; const float nf = (float)(n > 1 ? n : 1);
    int large = 8 + (int)(logf(nf / 8.0f) / 3.4657359027997265f * 8.0f); large = large < 15 ? large : 15;
    return (rel > 0 ? 16 : 0) + (n < 8 ? n : large);
}
namespace att {
#define ALAS __attribute__((address_space(3)))
using f32x16 = __attribute__((ext_vector_type(16))) float;
using s16x4 = __attribute__((ext_vector_type(4))) short;
using bf16x8 = __attribute__((ext_vector_type(8))) short;
using u32x4 = __attribute__((ext_vector_type(4))) unsigned;
constexpr int SLOT = 32768, SLOT_V = 16384, NSLOT = 4, TABN = 416, TOFF = 352, OFF_TAB = 131520, OFF_WS = OFF_TAB + 8 * TABN * 4, OFF_MISC = OFF_WS + 2048;
static_assert(OFF_MISC + 64 <= 147456, "attention LDS map");
constexpr float THR = 8.f;
#define KSWZ(row, colB) ((row) * 256 + ((colB) ^ (((row) & 7) << 4)))
#define SBAR() __builtin_amdgcn_sched_barrier(0)
__device__ __forceinline__ int crow(int r, int hi) { return (r & 3) + 8 * (r >> 2) + 4 * hi; }
__device__ __forceinline__ void glds16(const void* gsrc, unsigned lds_dst) {
  asm volatile("s_mov_b32 m0, %1\n\ts_nop 0\n\tglobal_load_lds_dwordx4 %0, off" :: "v"(gsrc), "s"(lds_dst) : "memory"); }
#define WAIT_BAR() asm volatile("s_waitcnt vmcnt(0) lgkmcnt(0)\n\ts_barrier" ::: "memory")
#define ENDSLOT() asm volatile("s_waitcnt vmcnt(4) lgkmcnt(0)\n\ts_barrier" ::: "memory")
__device__ __forceinline__ unsigned cvtpk(float lo, float hi) { unsigned r; asm volatile("v_cvt_pk_bf16_f32 %0, %1, %2" : "=v"(r) : "v"(lo), "v"(hi)); return r; }
__device__ __forceinline__ void partialSM(f32x16& p0, f32x16& p1, float& m_reg, float& mn, float& alpha, const ALAS float* tb, bool near, float bfar, bool kill) {
  if (near) {
#pragma unroll
    for (int r = 0; r < 16; ++r) { p0[r] += tb[(r & 3) + 8 * (r >> 2)]; p1[r] += tb[32 + (r & 3) + 8 * (r >> 2)]; } }
  if (kill) {
#pragma unroll
    for (int r = 0; r < 16; ++r) { p0[r] = -1e30f; p1[r] = -1e30f; } }
  float pmax = p0[0];
#pragma unroll
  for (int r = 1; r < 16; ++r) pmax = fmaxf(pmax, p0[r]);
#pragma unroll
  for (int r = 0; r < 16; ++r) pmax = fmaxf(pmax, p1[r]);
  { auto rr = __builtin_amdgcn_permlane32_swap(__float_as_uint(pmax), __float_as_uint(pmax), false, false);
    pmax = fmaxf(__uint_as_float(rr[0]), __uint_as_float(rr[1])); }
  const float bo = near ? 0.f : bfar;
  pmax += bo;
  if (__builtin_expect(__all(pmax - m_reg <= THR), 1)) { mn = m_reg; alpha = 1.f; }
  else { mn = fmaxf(m_reg, pmax); alpha = __builtin_amdgcn_exp2f(m_reg - mn); m_reg = mn; }
  const float sh = bo - mn;
#pragma unroll
  for (int r = 0; r < 16; ++r) { p0[r] += sh; p1[r] += sh; }
#pragma unroll
  for (int r = 0; r < 16; ++r) p0[r] = __builtin_amdgcn_exp2f(p0[r]);
}
__device__ __forceinline__ void finishSM(f32x16& p0, f32x16& p1, float alpha, float& l_reg, bf16x8& pa0, bf16x8& pa1, bf16x8& pa2, bf16x8& pa3) {
#pragma unroll
  for (int r = 0; r < 16; ++r) p1[r] = __builtin_amdgcn_exp2f(p1[r]);
  float ps = 0;
#pragma unroll
  for (int r = 0; r < 16; ++r) ps += p0[r];
#pragma unroll
  for (int r = 0; r < 16; ++r) ps += p1[r];
  { auto rr = __builtin_amdgcn_permlane32_swap(__float_as_uint(ps), __float_as_uint(ps), false, false);
    ps = __uint_as_float(rr[0]) + __uint_as_float(rr[1]); }
  l_reg = l_reg * alpha + ps;
#define PK4(P, BASE, OUT) do { unsigned a0 = cvtpk(P[BASE + 0], P[BASE + 1]), a1 = cvtpk(P[BASE + 2], P[BASE + 3]);   \
    unsigned b0 = cvtpk(P[BASE + 4], P[BASE + 5]), b1 = cvtpk(P[BASE + 6], P[BASE + 7]);                              \
    auto r0 = __builtin_amdgcn_permlane32_swap(a0, b0, false, false); auto r1 = __builtin_amdgcn_permlane32_swap(a1, b1, false, false); \
    u32x4 w = {r0[0], r1[0], r0[1], r1[1]}; OUT = *reinterpret_cast<bf16x8*>(&w); } while (0)
  PK4(p0, 0, pa0); PK4(p0, 8, pa1); PK4(p1, 0, pa2); PK4(p1, 8, pa3);
#undef PK4
}
__device__ __forceinline__ float psm_pre(f32x16& p0, f32x16& p1, float& m_reg, float& alpha, const ALAS float* tb, bool near, float bfar, bool kill) {
  if (near) {
#pragma unroll
    for (int r = 0; r < 16; ++r) { p0[r] += tb[(r & 3) + 8 * (r >> 2)]; p1[r] += tb[32 + (r & 3) + 8 * (r >> 2)]; } }
  float pmax = p0[0];
#pragma unroll
  for (int r = 1; r < 16; ++r) pmax = fmaxf(pmax, p0[r]);
#pragma unroll
  for (int r = 0; r < 16; ++r) pmax = fmaxf(pmax, p1[r]);
  { auto rr = __builtin_amdgcn_permlane32_swap(__float_as_uint(pmax), __float_as_uint(pmax), false, false);
    pmax = fmaxf(__uint_as_float(rr[0]), __uint_as_float(rr[1])); }
  const float bo = near ? 0.f : bfar;
  pmax = kill ? -1e30f : pmax + bo;
  float mn;
  if (__builtin_expect(__all(pmax - m_reg <= THR), 1)) { mn = m_reg; alpha = 1.f; }
  else { mn = fmaxf(m_reg, pmax); alpha = __builtin_amdgcn_exp2f(m_reg - mn); m_reg = mn; }
  return kill ? -1e30f : bo - mn;
}
__device__ __forceinline__ void finish_plain(const f32x16& p0, const f32x16& p1, float alpha, float& l_reg, bf16x8& pa0, bf16x8& pa1, bf16x8& pa2, bf16x8& pa3) {
  float ps = 0;
#pragma unroll
  for (int r = 0; r < 16; ++r) ps += p0[r];
#pragma unroll
  for (int r = 0; r < 16; ++r) ps += p1[r];
  { auto rr = __builtin_amdgcn_permlane32_swap(__float_as_uint(ps), __float_as_uint(ps), false, false);
    ps = __uint_as_float(rr[0]) + __uint_as_float(rr[1]); }
  l_reg = l_reg * alpha + ps;
#define PK4(P, BASE, OUT) do { u32x4 w = {cvtpk(P[BASE + 0], P[BASE + 1]), cvtpk(P[BASE + 2], P[BASE + 3]), cvtpk(P[BASE + 4], P[BASE + 5]), cvtpk(P[BASE + 6], P[BASE + 7])}; OUT = *reinterpret_cast<bf16x8*>(&w); } while (0)
  PK4(p0, 0, pa0); PK4(p0, 8, pa1); PK4(p1, 0, pa2); PK4(p1, 8, pa3);
#undef PK4
}
__device__ __forceinline__ void qkt(f32x16& p0, f32x16& p1, const ALAS char* Ks, const bf16x8* qr, int r32, int hi, int cbm) {
  p0 = f32x16{}; p1 = f32x16{};
#pragma unroll
  for (int d0 = 0; d0 < 4; ++d0) { const int cb = cbm + (d0 * 16 + hi * 8) * 2;
    const bf16x8 b0 = *(const ALAS bf16x8*)(Ks + KSWZ(r32, cb));
    const bf16x8 b1 = *(const ALAS bf16x8*)(Ks + KSWZ(32 + r32, cb));
    p0 = __builtin_amdgcn_mfma_f32_32x32x16_bf16(b0, qr[d0], p0, 0, 0, 0);
    p1 = __builtin_amdgcn_mfma_f32_32x32x16_bf16(b1, qr[d0], p1, 0, 0, 0); }
}
__device__ __forceinline__ int v_st(int k, int c) { const int kk = (k & ~0xC) | ((k & 4) << 1) | ((k & 8) >> 1); return ((kk >> 3) * 4 + (c >> 5)) * 512 + ((kk & 7) * 32 + (c & 31)) * 2; }
__device__ __forceinline__ int v_rd_base(int lane) { return ((lane & 3) << 3) | (((lane >> 2) & 3) << 6) | (((lane >> 4) & 1) << 5) | (((lane >> 5) & 1) << 8); }
constexpr int v_rd_off(int d0, int ks, int half) { return d0 * 512 + ks * 4096 + half * 2048; }
template <int OFF> __device__ __forceinline__ s16x4 tr_read(int vb) {
  s16x4 r; asm volatile("ds_read_b64_tr_b16 %0, %1 offset:%2" : "=&v"(r) : "v"(vb), "i"(OFF) : "memory"); return r;
}
#define PK(L, H) (bf16x8){L[0], L[1], L[2], L[3], H[0], H[1], H[2], H[3]}
#define VRD8(D0, l, h) do { l[0] = tr_read<v_rd_off(D0, 0, 0)>(vb); h[0] = tr_read<v_rd_off(D0, 0, 1)>(vb); l[1] = tr_read<v_rd_off(D0, 1, 0)>(vb); h[1] = tr_read<v_rd_off(D0, 1, 1)>(vb); \
    l[2] = tr_read<v_rd_off(D0, 2, 0)>(vb); h[2] = tr_read<v_rd_off(D0, 2, 1)>(vb); l[3] = tr_read<v_rd_off(D0, 3, 0)>(vb); h[3] = tr_read<v_rd_off(D0, 3, 1)>(vb); } while (0)
#define PVM(od, l, h) do { od = __builtin_amdgcn_mfma_f32_32x32x16_bf16(pa0, PK(l[0], h[0]), od, 0, 0, 0); od = __builtin_amdgcn_mfma_f32_32x32x16_bf16(pa1, PK(l[1], h[1]), od, 0, 0, 0); \
    od = __builtin_amdgcn_mfma_f32_32x32x16_bf16(pa2, PK(l[2], h[2]), od, 0, 0, 0); od = __builtin_amdgcn_mfma_f32_32x32x16_bf16(pa3, PK(l[3], h[3]), od, 0, 0, 0); } while (0)
#define PVM2(oa, ob, la_, ha_, lb_, hb_) do { \
    oa = __builtin_amdgcn_mfma_f32_32x32x16_bf16(pa0, PK(la_[0], ha_[0]), oa, 0, 0, 0); ob = __builtin_amdgcn_mfma_f32_32x32x16_bf16(pa0, PK(lb_[0], hb_[0]), ob, 0, 0, 0); \
    oa = __builtin_amdgcn_mfma_f32_32x32x16_bf16(pa1, PK(la_[1], ha_[1]), oa, 0, 0, 0); ob = __builtin_amdgcn_mfma_f32_32x32x16_bf16(pa1, PK(lb_[1], hb_[1]), ob, 0, 0, 0); \
    oa = __builtin_amdgcn_mfma_f32_32x32x16_bf16(pa2, PK(la_[2], ha_[2]), oa, 0, 0, 0); ob = __builtin_amdgcn_mfma_f32_32x32x16_bf16(pa2, PK(lb_[2], hb_[2]), ob, 0, 0, 0); \
    oa = __builtin_amdgcn_mfma_f32_32x32x16_bf16(pa3, PK(la_[3], ha_[3]), oa, 0, 0, 0); ob = __builtin_amdgcn_mfma_f32_32x32x16_bf16(pa3, PK(lb_[3], hb_[3]), ob, 0, 0, 0); } while (0)
__device__ __forceinline__ void pv_d0(f32x16* o, int vb, bf16x8 pa0, bf16x8 pa1, bf16x8 pa2, bf16x8 pa3) {
  s16x4 la[4], ha[4], lb[4], hb[4];
  SBAR();
  VRD8(0, la, ha); VRD8(1, lb, hb);
  asm volatile("s_waitcnt lgkmcnt(0)" ::: "memory"); SBAR(); PVM2(o[0], o[1], la, ha, lb, hb);
  VRD8(2, la, ha); VRD8(3, lb, hb);
  asm volatile("s_waitcnt lgkmcnt(0)" ::: "memory"); SBAR(); PVM2(o[2], o[3], la, ha, lb, hb);
}
template <bool PVON> __device__ __forceinline__ void m_slot(f32x16& c0, f32x16& c1, f32x16* o, int ka, const int (&koff)[4], const bf16x8* qr, int vb, bf16x8 pa0, bf16x8 pa1, bf16x8 pa2, bf16x8 pa3) {
  bf16x8 k0[4], k1[4]; s16x4 la[4], ha[4], lb[4], hb[4];
#define VRKS(KS, L, H) do { L[0] = tr_read<v_rd_off(0, KS, 0)>(vb); H[0] = tr_read<v_rd_off(0, KS, 1)>(vb); L[1] = tr_read<v_rd_off(1, KS, 0)>(vb); H[1] = tr_read<v_rd_off(1, KS, 1)>(vb); \
    L[2] = tr_read<v_rd_off(2, KS, 0)>(vb); H[2] = tr_read<v_rd_off(2, KS, 1)>(vb); L[3] = tr_read<v_rd_off(3, KS, 0)>(vb); H[3] = tr_read<v_rd_off(3, KS, 1)>(vb); } while (0)
#define PVKS(PA, L, H) do { o[0] = __builtin_amdgcn_mfma_f32_32x32x16_bf16(PA, PK(L[0], H[0]), o[0], 0, 0, 0); o[1] = __builtin_amdgcn_mfma_f32_32x32x16_bf16(PA, PK(L[1], H[1]), o[1], 0, 0, 0); \
    o[2] = __builtin_amdgcn_mfma_f32_32x32x16_bf16(PA, PK(L[2], H[2]), o[2], 0, 0, 0); o[3] = __builtin_amdgcn_mfma_f32_32x32x16_bf16(PA, PK(L[3], H[3]), o[3], 0, 0, 0); } while (0)
  SBAR();
#pragma unroll
  for (int d0 = 0; d0 < 4; ++d0) { asm volatile("ds_read_b128 %0, %1" : "=&v"(k0[d0]) : "v"(ka + koff[d0]) : "memory"); asm volatile("ds_read_b128 %0, %1 offset:8192" : "=&v"(k1[d0]) : "v"(ka + koff[d0]) : "memory"); }
  if (PVON) { VRKS(0, la, ha); asm volatile("s_waitcnt lgkmcnt(8)" ::: "memory"); } else asm volatile("s_waitcnt lgkmcnt(0)" ::: "memory");
  SBAR();
  c0 = __builtin_amdgcn_mfma_f32_32x32x16_bf16(k0[0], qr[0], f32x16{}, 0, 0, 0); c1 = __builtin_amdgcn_mfma_f32_32x32x16_bf16(k1[0], qr[0], f32x16{}, 0, 0, 0);
#pragma unroll
  for (int d0 = 1; d0 < 4; ++d0) { c0 = __builtin_amdgcn_mfma_f32_32x32x16_bf16(k0[d0], qr[d0], c0, 0, 0, 0); c1 = __builtin_amdgcn_mfma_f32_32x32x16_bf16(k1[d0], qr[d0], c1, 0, 0, 0); }
  if (PVON) {
    SBAR(); VRKS(1, lb, hb); asm volatile("s_waitcnt lgkmcnt(8)" ::: "memory"); SBAR(); PVKS(pa0, la, ha);
    SBAR(); VRKS(2, la, ha); asm volatile("s_waitcnt lgkmcnt(8)" ::: "memory"); SBAR(); PVKS(pa1, lb, hb);
    SBAR(); VRKS(3, lb, hb); asm volatile("s_waitcnt lgkmcnt(8)" ::: "memory"); SBAR(); PVKS(pa2, la, ha);
    asm volatile("s_waitcnt lgkmcnt(0)" ::: "memory"); SBAR(); PVKS(pa3, lb, hb);
  }
#undef VRKS
#undef PVKS
}
#undef PVM2
#undef PK
#undef VRD8
#undef PVM

template <int abl> __device__ __forceinline__ void attn_unit(const bf16* __restrict__ P, bf16* __restrict__ CAT, const float* __restrict__ g_sub, int b, int h, int u, int wave_id, ALAS char* lds) {
  if (abl & 1024) { __syncthreads(); return; }
  const int lane = lane_id(), wid = wave_id,
  tid = wid * 64 + lane, r32 = lane & 31, hi = lane >> 5, sub = wid >> 1, mp = wid & 1;
  ALAS char* K_lds = lds;
  ALAS float* ws = (ALAS float*)(lds + OFF_WS) + wid * 64; ALAS float* li_l = ws; ALAS float* al_l = ws + 32;
  const ALAS float* tab = (const ALAS float*)(lds + OFF_TAB) + h * TABN;
  const int q0w = u * 128 + sub * 32, NT = 2 * u + 2;
  const bool mask_last = (sub < 2);
  const int jn = (q0w >= 319) ? (q0w - 319) / 64 + 1 : 0;
  const float bfar = tab[TOFF - 256];
  const ALAS float* tb0 = tab + (TOFF - q0w - r32 + 4 * hi);
  const size_t rowb = (size_t)b * SEQ;
  const bf16* Kh = P + rowb * NPROJ + C_KA + h * 128; const bf16* Vh = P + rowb * NPROJ + C_VA + h * 128;
  unsigned ksrc[2], vsrc[2];
#pragma unroll
  for (int i = 0; i < 2; ++i) { const int row = wid * 8 + i * 4 + (lane >> 4), ch = (lane & 15) ^ (row & 7); ksrc[i] = (unsigned)(row * NPROJ + ch * 8) * 2u;
    const int ob = wid * 2048 + i * 1024 + lane * 16, st = ob >> 9, we = (ob & 511) >> 1, kk = 8 * (st >> 2) + (we >> 5), c = 32 * (st & 3) + (we & 31), k = kk;
    vsrc[i] = (unsigned)(k * NPROJ + c) * 2u; }
  const unsigned ldsb = (unsigned)(uintptr_t)lds, kdst = ldsb + (unsigned)wid * 2048u, vdst = kdst + SLOT_V;
#define DMA_TILE(t, so) do { const char* kg = (const char*)Kh + (size_t)(t) * (64 * NPROJ * 2); const char* vg = (const char*)Vh + (size_t)(t) * (64 * NPROJ * 2); \
    glds16(kg + ksrc[0], (unsigned)__builtin_amdgcn_readfirstlane(kdst + (so))); glds16(kg + ksrc[1], (unsigned)__builtin_amdgcn_readfirstlane(kdst + 1024 + (so))); \
    glds16(vg + vsrc[0], (unsigned)__builtin_amdgcn_readfirstlane(vdst + (so))); glds16(vg + vsrc[1], (unsigned)__builtin_amdgcn_readfirstlane(vdst + 1024 + (so))); } while (0)
  DMA_TILE(0, 0); DMA_TILE(1, SLOT);
  float m_reg = -1e30f, l_reg = 0; f32x16 o[4] = {}; bf16x8 qr[4];
  { const bf16* Qu = P + (rowb + q0w) * NPROJ + C_QA + h * 128 + mp * 64; const unsigned qo = (unsigned)(r32 * NPROJ + hi * 8);
#pragma unroll
    for (int d0 = 0; d0 < 4; ++d0) qr[d0] = *reinterpret_cast<const bf16x8*>(Qu + qo + d0 * 16); }
  const int cbm = mp * 128;
  const int vb0 = (int)ldsb + SLOT_V + v_rd_base(lane);
#define RESC(a) do { if (__any((a) < 1.f)) { if (hi == 0) al_l[r32] = (a); asm volatile("s_waitcnt lgkmcnt(0)" ::: "memory"); \
    _Pragma("unroll") for (int d = 0; d < 4; ++d) _Pragma("unroll") for (int r = 0; r < 16; ++r) o[d][r] *= al_l[crow(r, hi)]; } } while (0)
#define PSM(P0, P1, MN, AL, t) partialSM(P0, P1, m_reg, MN, AL, tb0 + 64 * (t), (t) >= jn, bfar, mask_last && ((t) == NT - 1))
  f32x16 c0, c1; float al = 1.f; bf16x8 pa0 = {}, pa1 = {}, pa2 = {}, pa3 = {};
  int koff[4];
#pragma unroll
  for (int d0 = 0; d0 < 4; ++d0) koff[d0] = KSWZ(r32, cbm + d0 * 32 + hi * 16);
  const bool grpB = (wid >= 4);
#define SLOTOF(t) (((t) & (NSLOT - 1)) * SLOT)
#define MQK(t) do { __builtin_amdgcn_s_setprio(1); if (!(abl & 1)) qkt(c0, c1, K_lds + SLOTOF(t), qr, r32, hi, cbm); } while (0)
#define MPV(t) do { if (!(abl & 2)) pv_d0(o, vb0 + SLOTOF(t), pa0, pa1, pa2, pa3); __builtin_amdgcn_s_setprio(0); } while (0)
#define VSM(t) do { if (abl & 4) break; const float sh_ = psm_pre(c0, c1, m_reg, al, tb0 + 64 * (t), (t) >= jn, bfar, mask_last && ((t) == NT - 1)); RESC(al); \
    if (!(abl & 8)) { _Pragma("unroll") for (int r = 0; r < 16; ++r) { c0[r] = __builtin_amdgcn_exp2f(c0[r] + sh_); c1[r] = __builtin_amdgcn_exp2f(c1[r] + sh_); } } \
    if (!(abl & 16)) finish_plain(c0, c1, al, l_reg, pa0, pa1, pa2, pa3); } while (0)
#define ENDS(t) do { if ((t) + 2 >= NT) WAIT_BAR(); else ENDSLOT(); } while (0)
  if (2 < NT) DMA_TILE(2, 2 * SLOT);
  WAIT_BAR();
  if (grpB) ENDSLOT();
  MQK(0);
  ENDS(0);
  if (grpB && 3 < NT) DMA_TILE(3, 3 * SLOT);
  VSM(0); ENDS(0);
#pragma unroll 1
  for (int t = 1; t < NT; ++t) {
    MQK(t); MPV(t - 1); ENDS(t);
    if (!grpB && t + 2 < NT) DMA_TILE(t + 2, SLOTOF(t + 2));
    if (grpB && t + 3 < NT) DMA_TILE(t + 3, SLOTOF(t + 3));
    VSM(t); ENDS(t);
  }
  MPV(NT - 1);
  if (!grpB) ENDSLOT();
#undef ENDS
#undef SLOTOF
#undef MQK
#undef MPV
#undef VSM
  if (hi == 0) li_l[r32] = l_reg; asm volatile("s_waitcnt lgkmcnt(0)" ::: "memory");
  float rli[16];
#pragma unroll
  for (int r = 0; r < 16; ++r) rli[r] = __builtin_amdgcn_rcpf(li_l[crow(r, hi)]);
  __syncthreads();
  ALAS float* X = (ALAS float*)lds + sub * 4096 + lane;
  if (mp == 1) {
#pragma unroll
    for (int d0 = 0; d0 < 4; ++d0)
#pragma unroll
      for (int r = 0; r < 16; ++r) X[(d0 * 16 + r) * 64] = o[d0][r] * rli[r]; }
  __syncthreads();
  if (mp == 0) {
    const float lam = *(const ALAS float*)(lds + OFF_MISC);
    float ss[16];
#pragma unroll
    for (int r = 0; r < 16; ++r) ss[r] = 0.f;
#pragma unroll
    for (int d0 = 0; d0 < 4; ++d0)
#pragma unroll
      for (int r = 0; r < 16; ++r) { const float v = o[d0][r] * rli[r] - lam * X[(d0 * 16 + r) * 64]; o[d0][r] = v; ss[r] += v * v; }
#pragma unroll
    for (int r = 0; r < 16; ++r) {
      ss[r] = half_sum(ss[r]);
      ss[r] = rsqrtf(ss[r] * (1.f / 128.f) + EPS) * (1.f - LAM_INIT); }
    bf16* Ou = CAT + (rowb + q0w) * DM + h * 128; const unsigned oo = (unsigned)(4 * hi * DM + r32);
#pragma unroll
    for (int d0 = 0; d0 < 4; ++d0) { const float gd = g_sub[32 * d0 + r32];
#pragma unroll
      for (int r = 0; r < 16; ++r) Ou[oo + (unsigned)(((r & 3) + 8 * (r >> 2)) * DM + 32 * d0)] = (bf16)f2bf(o[d0][r] * ss[r] * gd); }
  }
  __syncthreads();
#undef DMA_TILE
#undef RESC
#undef PSM
}
#undef KSWZ
#undef SBAR
#undef WAIT_BAR
#undef ALAS
}
namespace gla {
#define GLAS __attribute__((address_space(3)))
using f32x16 = __attribute__((ext_vector_type(16))) float;
using s16x4 = __attribute__((ext_vector_type(4))) short;
using bf16x8 = __attribute__((ext_vector_type(8))) short;
typedef float f32x2_t __attribute__((ext_vector_type(2))); typedef __bf16 bf16x2_t __attribute__((ext_vector_type(2)));
__device__ __forceinline__ unsigned cvt2(float lo, float hi) { f32x2_t v = {lo, hi}; bf16x2_t b = __builtin_convertvector(v, bf16x2_t); return __builtin_bit_cast(unsigned, b); }
constexpr int KD_STRIDE = 144, V_STRIDE = 576, Q_STRIDE = 264, GCH = 8;
constexpr size_t GS_SLOT = 131584;
constexpr int OFF_KDT = 0, OFF_V = 18432, OFF_Q = 80960, OFF_DEC = 97856, OFF_TOTP = 98368, OFF_SSP = 99392, OFF_K = 101440, OFF_GN = 118336;
__device__ __forceinline__ int crow(int r, int hi) { return (r & 3) + 8 * (r >> 2) + 4 * hi; }
template <int OFF> __device__ __forceinline__ s16x4 tr_read(int vb) {
  s16x4 r; asm volatile("ds_read_b64_tr_b16 %0, %1 offset:%2" : "=&v"(r) : "v"(vb), "i"(OFF) : "memory"); return r;
}
__device__ __forceinline__ void gla_unit(const bf16* __restrict__ P, const float* __restrict__ ZB, const float* __restrict__ w_alpha, const float* __restrict__ b_alpha, const float* __restrict__ g_norm_b,
                                         bf16* __restrict__ CAT, int b, int hb, int grp, int mode, unsigned char* GS, unsigned* gflags, unsigned* tmo, int wave_id, GLAS char* lds) {
  const int lane = lane_id(), w = wave_id,
  tid = w * 64 + lane, r32 = lane & 31, hi = lane >> 5, cb = w >> 2, db = w & 3;
  GLAS float* dec = (GLAS float*)(lds + OFF_DEC); GLAS float* totp = (GLAS float*)(lds + OFF_TOTP); GLAS float* ssp = (GLAS float*)(lds + OFF_SSP);
  bf16x8 wa;
#pragma unroll
  for (int j = 0; j < 8; ++j) wa[j] = (short)f2bf(w_alpha[(8 * hi + j) * 512 + hb * 128 + 32 * db + r32]);
  const float ba = b_alpha[hb * 128 + 32 * db + r32];
  if (tid < 256) ((GLAS float*)(lds + OFF_GN))[tid] = g_norm_b[tid];
  f32x16 S[4] = {};
  const size_t rowb = (size_t)b * SEQ;
  const int gid = b * 4 + hb;
  if (mode == 1 && grp > 0) {
    if (w == 0) {
      for (int j = 0; j < grp; ++j) { unsigned sp = 0;
        while (__hip_atomic_load(gflags + 64 * (gid * 7 + j), __ATOMIC_RELAXED, __HIP_MEMORY_SCOPE_AGENT) == 0u) { __builtin_amdgcn_s_sleep(4);
          if (++sp > (1u << 21)) { __hip_atomic_store(tmo, 1u, __ATOMIC_RELAXED, __HIP_MEMORY_SCOPE_AGENT); break; } } } }
    __syncthreads();
#pragma unroll 1
    for (int j = 0; j < grp; ++j) {
      const unsigned char* slot = GS + (size_t)(gid * 7 + j) * GS_SLOT;
      if (tid < 128) dec[tid] = __uint_as_float(__hip_atomic_load((const unsigned*)(slot + 131072) + tid, __ATOMIC_RELAXED, __HIP_MEMORY_SCOPE_AGENT));
      unsigned long long Lt[32];
      const unsigned long long* lp = (const unsigned long long*)slot + (size_t)(w * 2048 + lane);
#pragma unroll
      for (int i = 0; i < 32; ++i) Lt[i] = __hip_atomic_load(lp + (i >> 3) * 512 + (i & 7) * 64, __ATOMIC_RELAXED, __HIP_MEMORY_SCOPE_AGENT);
      __syncthreads();
#pragma unroll
      for (int dblk = 0; dblk < 4; ++dblk)
#pragma unroll
        for (int g = 0; g < 4; ++g) { const f32x4 dv = *(GLAS f32x4*)(dec + 32 * dblk + 8 * g + 4 * hi);
#pragma unroll
          for (int jj = 0; jj < 4; ++jj) { const unsigned long long t = Lt[dblk * 8 + 2 * g + (jj >> 1)]; const float lv = __uint_as_float((jj & 1) ? (unsigned)(t >> 32) : (unsigned)t);
            S[dblk][4 * g + jj] = S[dblk][4 * g + jj] * dv[jj] + lv; } }
      __syncthreads();
    }
  }
  float Tsum = 0.f;
  const unsigned vo = (unsigned)((tid >> 5) * NPROJ + C_VB + hb * 256 + (tid & 31) * 8), qo = (unsigned)((tid >> 4) * NPROJ + C_QB + hb * 128 + (tid & 15) * 8);
  const unsigned ko = (unsigned)((tid >> 4) * NPROJ + C_KB + hb * 128 + (tid & 15) * 8);
  const unsigned zo = (unsigned)((32 * cb + r32) * 16 + 8 * hi);
  const unsigned ro = (unsigned)(r32 * NPROJ + C_RB + hb * 256 + 32 * w + 4 * hi);
  const int l0 = (int)(unsigned)(uintptr_t)lds;
  int vwr = l0 + OFF_V + (tid >> 5) * V_STRIDE + (tid & 31) * 16, qwr = l0 + OFF_Q + (tid >> 4) * Q_STRIDE + (tid & 15) * 16;
  int kdw = l0 + OFF_KDT + (32 * db + r32) * KD_STRIDE + (32 * cb + 4 * hi) * 2;
  int kwr = l0 + OFF_K + (tid >> 4) * Q_STRIDE + (tid & 15) * 16, krd = l0 + OFF_K + (32 * cb + 4 * hi) * Q_STRIDE + (32 * db + r32) * 2, gnb = l0 + OFF_GN + (32 * w + 4 * hi) * 4;
  int totw = l0 + OFF_TOTP + (cb * 128 + 32 * db + r32) * 4, totr = l0 + OFF_TOTP + (32 * db + r32) * 4, decw = l0 + OFF_DEC + (32 * db + r32) * 4;
  int qb = l0 + OFF_Q + r32 * Q_STRIDE + 8 * hi, kdb = l0 + OFF_KDT + r32 * KD_STRIDE + 16 * hi, decb = l0 + OFF_DEC + 16 * hi, sspb = l0 + OFF_SSP + 4 * r32;
  asm volatile("" : "+v"(vwr), "+v"(qwr), "+v"(kdw), "+v"(qb), "+v"(kdb), "+v"(decb), "+v"(sspb), "+v"(kwr), "+v"(krd), "+v"(gnb), "+v"(totw), "+v"(totr), "+v"(decw));
#define LP(T, a) ((GLAS T*)(unsigned)(a))
  const int i16 = lane & 15, vrd = (int)(unsigned)(uintptr_t)lds + OFF_V + (8 * hi + (i16 >> 2)) * V_STRIDE + (32 * w + 16 * ((lane >> 4) & 1) + 4 * (i16 & 3)) * 2;
  bf16x8 pv[4], pq[2], pk[2]; f32x4 pz[2];
#define GLOADV(n) do { const bf16* Pt = P + (rowb + (size_t)(n) * 64) * NPROJ; \
    _Pragma("unroll") for (int i = 0; i < 4; ++i) pv[i] = *reinterpret_cast<const bf16x8*>(Pt + vo + (unsigned)(16 * i * NPROJ)); } while (0)
#define GLOAD(n) do { const bf16* Pt = P + (rowb + (size_t)(n) * 64) * NPROJ; const float* Zt = ZB + (rowb + (size_t)(n) * 64) * 16; \
    _Pragma("unroll") for (int i = 0; i < 2; ++i) pq[i] = *reinterpret_cast<const bf16x8*>(Pt + qo + (unsigned)(32 * i * NPROJ)); \
    pz[0] = *reinterpret_cast<const f32x4*>(Zt + zo); pz[1] = *reinterpret_cast<const f32x4*>(Zt + zo + 4); \
    _Pragma("unroll") for (int i = 0; i < 2; ++i) pk[i] = *reinterpret_cast<const bf16x8*>(Pt + ko + (unsigned)(32 * i * NPROJ)); } while (0)
  GLOAD(grp * GCH); GLOADV(grp * GCH);
#pragma unroll 1
  for (int nn = 0; nn < GCH; ++nn) {
    const int n = grp * GCH + nn;
    const size_t t0 = rowb + (size_t)n * 64;
    float la[16], Tcb;
    { bf16x8 za; { const unsigned a0 = cvt2(pz[0][0], pz[0][1]), a1 = cvt2(pz[0][2], pz[0][3]), a2 = cvt2(pz[1][0], pz[1][1]), a3 = cvt2(pz[1][2], pz[1][3]);
        u32x4 t = {a0, a1, a2, a3}; za = __builtin_bit_cast(bf16x8, t); }
      f32x16 pre;
#pragma unroll
      for (int r = 0; r < 16; ++r) pre[r] = ba;
      pre = __builtin_amdgcn_mfma_f32_32x32x16_bf16(za, wa, pre, 0, 0, 0);
#pragma unroll
      for (int r = 0; r < 16; ++r) { const float xx = pre[r]; la[r] = (fminf(xx, 0.f) - 0.6931471805599453f * __builtin_amdgcn_logf(1.f + __builtin_amdgcn_exp2f(-1.4426950408889634f * fabsf(xx)))) * (1.f / 16.f); }
      float run = 0.f;
#pragma unroll
      for (int g = 0; g < 4; ++g) { la[4 * g + 1] += la[4 * g]; la[4 * g + 2] += la[4 * g + 1]; la[4 * g + 3] += la[4 * g + 2];
        const float G = la[4 * g + 3];
        auto rr = __builtin_amdgcn_permlane32_swap(__float_as_uint(G), __float_as_uint(G), false, false);
        const float G0 = __uint_as_float(rr[0]), G1 = __uint_as_float(rr[1]);
        const float off = run + (hi ? G0 : 0.f);
        la[4 * g] += off; la[4 * g + 1] += off; la[4 * g + 2] += off; la[4 * g + 3] += off; run += G0 + G1; }
      Tcb = run;
      if (hi == 0) *LP(float, totw) = Tcb; }
#pragma unroll
    for (int i = 0; i < 4; ++i) *LP(bf16x8, vwr + 16 * i * V_STRIDE) = pv[i];
    if (mode)
#pragma unroll
    for (int i = 0; i < 2; ++i) { const u32x4 t = __builtin_bit_cast(u32x4, pq[i]); *LP(u32x2, qwr + 32 * i * Q_STRIDE) = (u32x2){t.x, t.y}; *LP(u32x2, qwr + 32 * i * Q_STRIDE + 8) = (u32x2){t.z, t.w}; }
#pragma unroll
    for (int i = 0; i < 2; ++i) { const u32x4 t = __builtin_bit_cast(u32x4, pk[i]); *LP(u32x2, kwr + 32 * i * Q_STRIDE) = (u32x2){t.x, t.y}; *LP(u32x2, kwr + 32 * i * Q_STRIDE + 8) = (u32x2){t.z, t.w}; }
    __syncthreads();
    { const float t0v = *LP(float, totr), t1v = *LP(float, totr + 512), total = t0v + t1v, base = cb ? t0v : 0.f;
      unsigned short kk[16];
#pragma unroll
      for (int g = 0; g < 4; ++g)
#pragma unroll
        for (int j = 0; j < 4; ++j) kk[4 * g + j] = *LP(unsigned short, krd + (8 * g + j) * Q_STRIDE);
      asm volatile("s_waitcnt lgkmcnt(0)" ::: "memory");
#pragma unroll
      for (int g = 0; g < 4; ++g) { float kd[4];
#pragma unroll
        for (int j = 0; j < 4; ++j) kd[j] = __uint_as_float((unsigned)kk[4 * g + j] << 16) * __builtin_amdgcn_exp2f(1.4426950408889634f * (total - (la[4 * g + j] + base)));
        *LP(u32x2, kdw + 16 * g) = (u32x2){cvt2(kd[0], kd[1]), cvt2(kd[2], kd[3])}; }
      Tsum += total;
      if (cb == 0 && hi == 0) *LP(float, decw) = __expf(total); }
    __syncthreads();
    if (nn + 1 < GCH) GLOAD(n + 1);
    u32x2 rbv[2][4] = {};
    if (mode) { const bf16* Rt = P + t0 * NPROJ;
#pragma unroll
      for (int cblk = 0; cblk < 2; ++cblk)
#pragma unroll
        for (int g = 0; g < 4; ++g) rbv[cblk][g] = *reinterpret_cast<const u32x2*>(Rt + ro + (unsigned)(32 * cblk * NPROJ + 8 * g)); }
    bf16x8 vf[4];
    { s16x4 lo[4], hh[4];
      lo[0] = tr_read<0>(vrd); hh[0] = tr_read<4 * V_STRIDE>(vrd); lo[1] = tr_read<16 * V_STRIDE>(vrd); hh[1] = tr_read<20 * V_STRIDE>(vrd);
      lo[2] = tr_read<32 * V_STRIDE>(vrd); hh[2] = tr_read<36 * V_STRIDE>(vrd); lo[3] = tr_read<48 * V_STRIDE>(vrd); hh[3] = tr_read<52 * V_STRIDE>(vrd);
      asm volatile("s_waitcnt lgkmcnt(0)" ::: "memory"); __builtin_amdgcn_sched_barrier(0);
#pragma unroll
      for (int s = 0; s < 4; ++s) vf[s] = (bf16x8){lo[s][0], lo[s][1], lo[s][2], lo[s][3], hh[s][0], hh[s][1], hh[s][2], hh[s][3]}; }
    f32x16 z[2] = {};
#pragma unroll
    for (int dblk = 0; dblk < 4; ++dblk) {
#pragma unroll
      for (int g = 0; g < 4; ++g) { const f32x4 dv = *LP(f32x4, decb + 128 * dblk + 32 * g);
#pragma unroll
        for (int j = 0; j < 4; ++j) S[dblk][4 * g + j] *= dv[j]; }
#pragma unroll
      for (int s = 0; s < 4; ++s) { const bf16x8 af = *LP(bf16x8, kdb + 32 * dblk * KD_STRIDE + 32 * s);
        S[dblk] = __builtin_amdgcn_mfma_f32_32x32x16_bf16(af, vf[s], S[dblk], 0, 0, 0); }
      if (mode)
#pragma unroll
      for (int s2 = 0; s2 < 2; ++s2) {
        const u32x4 xt = {cvt2(S[dblk][8 * s2], S[dblk][8 * s2 + 1]), cvt2(S[dblk][8 * s2 + 2], S[dblk][8 * s2 + 3]), cvt2(S[dblk][8 * s2 + 4], S[dblk][8 * s2 + 5]), cvt2(S[dblk][8 * s2 + 6], S[dblk][8 * s2 + 7])};
        const bf16x8 xs = __builtin_bit_cast(bf16x8, xt);
#pragma unroll
        for (int cblk = 0; cblk < 2; ++cblk) { const int qa = qb + 32 * cblk * Q_STRIDE + 64 * dblk + 32 * s2;
          const u32x2 q0 = *LP(u32x2, qa), q1 = *LP(u32x2, qa + 16);
          const u32x4 qt = {q0.x, q0.y, q1.x, q1.y};
          z[cblk] = __builtin_amdgcn_mfma_f32_32x32x16_bf16(xs, __builtin_bit_cast(bf16x8, qt), z[cblk], 0, 0, 0); } }
    }
    if (nn + 1 < GCH) GLOADV(n + 1);
    if (mode) {
#pragma unroll
    for (int cblk = 0; cblk < 2; ++cblk) { float s = 0.f;
#pragma unroll
      for (int r = 0; r < 16; ++r) s += z[cblk][r] * z[cblk][r];
      auto rr = __builtin_amdgcn_permlane32_swap(__float_as_uint(s), __float_as_uint(s), false, false);
      s = __uint_as_float(rr[0]) + __uint_as_float(rr[1]);
      if (hi == 0) *LP(float, sspb + 256 * w + 128 * cblk) = s; }
    __syncthreads();
#pragma unroll
    for (int cblk = 0; cblk < 2; ++cblk) { float tot = 0.f;
#pragma unroll
      for (int ww = 0; ww < 8; ++ww) tot += *LP(float, sspb + 256 * ww + 128 * cblk);
      const float rs = rsqrtf(tot * (1.f / 256.f) + EPS);
      bf16* Ot = CAT + (t0 + 32 * cblk + r32) * DM + 1024 + hb * 256 + 32 * w + 4 * hi;
#pragma unroll
      for (int g = 0; g < 4; ++g) { const u32x2 rw = rbv[cblk][g]; float o4[4]; const f32x4 gq = *LP(f32x4, gnb + 32 * g);
        const float r0 = __uint_as_float(rw.x << 16), r1 = __uint_as_float(rw.x & 0xffff0000u), r2 = __uint_as_float(rw.y << 16), r3 = __uint_as_float(rw.y & 0xffff0000u);
#define GLA_SILU(v) ((v) * __builtin_amdgcn_rcpf(1.f + __builtin_amdgcn_exp2f(-1.4426950408889634f * (v))))
        o4[0] = z[cblk][4 * g] * rs * gq[0] * GLA_SILU(r0); o4[1] = z[cblk][4 * g + 1] * rs * gq[1] * GLA_SILU(r1);
        o4[2] = z[cblk][4 * g + 2] * rs * gq[2] * GLA_SILU(r2); o4[3] = z[cblk][4 * g + 3] * rs * gq[3] * GLA_SILU(r3);
#undef GLA_SILU
        *reinterpret_cast<u32x2*>(Ot + 8 * g) = (u32x2){cvt2(o4[0], o4[1]), cvt2(o4[2], o4[3])}; } }
    }
  }
  if (mode == 0) {
    unsigned char* slot = GS + (size_t)(gid * 7 + grp) * GS_SLOT;
    const int lane2 = lane_id(), r32 = lane2 & 31, hi = lane2 >> 5;
    unsigned long long* lp = (unsigned long long*)slot + (size_t)(w * 2048 + lane2);
#pragma unroll
    for (int dblk = 0; dblk < 4; ++dblk)
#pragma unroll
      for (int i = 0; i < 8; ++i) __hip_atomic_store(lp + dblk * 512 + i * 64, ((unsigned long long)__float_as_uint(S[dblk][2 * i + 1]) << 32) | (unsigned long long)__float_as_uint(S[dblk][2 * i]), __ATOMIC_RELAXED, __HIP_MEMORY_SCOPE_AGENT);
    if (cb == 0 && hi == 0) __hip_atomic_store((unsigned*)(slot + 131072) + 32 * db + r32, __float_as_uint(__expf(Tsum)), __ATOMIC_RELAXED, __HIP_MEMORY_SCOPE_AGENT);
    asm volatile("s_waitcnt vmcnt(0)" ::: "memory");
    __syncthreads();
    if (w == 0 && lane2 == 0) __hip_atomic_store(gflags + 64 * (gid * 7 + grp), 1u, __ATOMIC_RELAXED, __HIP_MEMORY_SCOPE_AGENT);
  }
  __syncthreads();
#undef GLOAD
#undef GLOADV
#undef LP
}
#undef GLAS
}
constexpr int NWAVES = 8;
constexpr int RING_OFF = 0, RING_BYTES = 131072;
constexpr int LDSCTL_OFF = RING_BYTES, MISC_OFF = LDSCTL_OFF + 320;
constexpr int LDS_BYTES = 147456;
constexpr int CW_CNT = 0;
constexpr int CW_BAR = 4096;
constexpr int N_PHASES = 9;
struct Frame {
    LAS unsigned char* lds;
    volatile LAS unsigned* MISC;
    gu32* ctl;
    int wave, G;
};
struct Args { const float* in[26]; float* out; unsigned char* ws; int ph_lo, ph_hi, li, pad; };

__device__ __forceinline__ void p0_ada_item(Frame& F, const float* __restrict__ c, const float* __restrict__ w_ada, float* __restrict__ part, int it) {
    const int lane = lane_id(), tid = F.wave * 64 + lane;
    const int jc = it % 48, kq = it / 48, j0 = jc * 256 + 4 * lane, k0 = kq * 512 + F.wave * 64;
    float s[4];
#pragma unroll
    for (int b = 0; b < 4; ++b) { const float cv = c[b * DM + k0 + lane]; s[b] = cv / (1.f + __expf(-cv)); }
    f32x4 acc[4];
#pragma unroll
    for (int b = 0; b < 4; ++b) acc[b] = (f32x4){0.f, 0.f, 0.f, 0.f};
#pragma unroll 16
    for (int i = 0; i < 64; ++i) { const f32x4 w = *(const GAS f32x4*)(w_ada + (size_t)(k0 + i) * NADA + j0);
#pragma unroll
        for (int b = 0; b < 4; ++b) acc[b] += w * __shfl(s[b], i); }
    LAS float* red = (LAS float*)(F.lds + RING_OFF);
#pragma unroll
    for (int b = 0; b < 4; ++b) *(LAS f32x4*)(red + (F.wave * 4 + b) * 256 + 4 * lane) = acc[b];
    __syncthreads();
    for (int o = tid; o < 1024; o += NWAVES * 64) { float t = 0.f;
#pragma unroll
        for (int w = 0; w < 8; ++w) t += red[w * 1024 + o];
        part[(size_t)(kq * 4 + (o >> 8)) * NADA + jc * 256 + (o & 255)] = t; }
    __syncthreads();
}
__device__ __forceinline__ void p0_transpose_item(const float* __restrict__ W, int K, int Ncols, int ldw, bf16* __restrict__ WT, int rs_hi, int off, LAS float* scr, int item, int lane) {
    const int nblk = Ncols / 32, kb = item / nblk, nb = item % nblk, k0 = 64 * kb, n0 = 32 * nb;
#pragma unroll
    for (int i = 0; i < 32; ++i) { const int kk = 2 * i + (lane >> 5); scr[kk * 33 + (lane & 31)] = W[(size_t)(k0 + kk) * ldw + n0 + (lane & 31)]; }
    LDS_WAIT(); asm volatile("" ::: "memory");
    const int c = lane & 7;
#pragma unroll
    for (int j = 0; j < 4; ++j) { const int nl = (lane >> 3) + 8 * j, n = n0 + nl; const LAS float* s = scr + (8 * c) * 33 + nl;
        v4u o; o.x = pk2(s[0 * 33], s[1 * 33]); o.y = pk2(s[2 * 33], s[3 * 33]); o.z = pk2(s[4 * 33], s[5 * 33]); o.w = pk2(s[6 * 33], s[7 * 33]);
        const int row = (n >> 7) * rs_hi + off + (n & 127);
        *(GAS v4u*)(WT + (size_t)row * K + k0 + 8 * c) = o; }
    LDS_WAIT(); asm volatile("" ::: "memory");
}
__device__ __forceinline__ void p0_transpose_item_f8(const float* __restrict__ W, int K, int Ncols, int ldw, unsigned char* __restrict__ WT, int rs_hi, int off, LAS float* scr, int item, int lane) {
    const int nblk = Ncols / 32, kb = item / nblk, nb = item % nblk, k0 = 64 * kb, n0 = 32 * nb;
#pragma unroll
    for (int i = 0; i < 32; ++i) { const int kk = 2 * i + (lane >> 5); scr[kk * 33 + (lane & 31)] = W[(size_t)(k0 + kk) * ldw + n0 + (lane & 31)]; }
    LDS_WAIT(); asm volatile("" ::: "memory");
    const int c = lane & 3;
#pragma unroll
    for (int j = 0; j < 2; ++j) { const int nl = (lane >> 2) + 16 * j, n = n0 + nl; const LAS float* s = scr + (16 * c) * 33 + nl;
        v4u o; o.x = pk4_fp8(s[0 * 33] * F8_WSCALE, s[1 * 33] * F8_WSCALE, s[2 * 33] * F8_WSCALE, s[3 * 33] * F8_WSCALE); o.y = pk4_fp8(s[4 * 33] * F8_WSCALE, s[5 * 33] * F8_WSCALE, s[6 * 33] * F8_WSCALE, s[7 * 33] * F8_WSCALE);
        o.z = pk4_fp8(s[8 * 33] * F8_WSCALE, s[9 * 33] * F8_WSCALE, s[10 * 33] * F8_WSCALE, s[11 * 33] * F8_WSCALE); o.w = pk4_fp8(s[12 * 33] * F8_WSCALE, s[13 * 33] * F8_WSCALE, s[14 * 33] * F8_WSCALE, s[15 * 33] * F8_WSCALE);
        const int row = (n >> 7) * rs_hi + off + (n & 127);
        *(GAS v4u*)(WT + (size_t)row * K + k0 + 16 * c) = o; }
    LDS_WAIT(); asm volatile("" ::: "memory");
}
__device__ __forceinline__ void p0_colmax_item(const float* __restrict__ W, int Ncols, int ldw, unsigned* __restrict__ cmax, int item, int lane) {
    const int nblk = Ncols / 32, kb = item / nblk, nb = item % nblk, k0 = 64 * kb, n0 = 32 * nb;
    float m = 0.f;
#pragma unroll
    for (int i = 0; i < 32; ++i) { const int kk = 2 * i + (lane >> 5); m = fmaxf(m, fabsf(W[(size_t)(k0 + kk) * ldw + n0 + (lane & 31)])); }
    auto rr = __builtin_amdgcn_permlane32_swap(__float_as_uint(m), __float_as_uint(m), false, false);
    m = fmaxf(__uint_as_float(rr[0]), __uint_as_float(rr[1]));
    if (lane < 32) __hip_atomic_fetch_max(cmax + n0 + lane, __float_as_uint(m), __ATOMIC_RELAXED, __HIP_MEMORY_SCOPE_AGENT);
}
__device__ __forceinline__ void p1_wq_item(const float* __restrict__ W, int K, int Ncols, int ldw, const unsigned* __restrict__ cmax, unsigned char* __restrict__ WT, LAS float* scr, int item, int lane) {
    const int nblk = Ncols / 32, kb = item / nblk, nb = item % nblk, k0 = 64 * kb, n0 = 32 * nb;
#pragma unroll
    for (int i = 0; i < 32; ++i) { const int kk = 2 * i + (lane >> 5); scr[kk * 33 + (lane & 31)] = W[(size_t)(k0 + kk) * ldw + n0 + (lane & 31)]; }
    LDS_WAIT(); asm volatile("" ::: "memory");
    const int c = lane & 3;
#pragma unroll
    for (int j = 0; j < 2; ++j) { const int nl = (lane >> 2) + 16 * j, n = n0 + nl; const LAS float* s = scr + (16 * c) * 33 + nl;
        const float qs = 127.f / fmaxf(__uint_as_float(cmax[n]), 1e-30f);
        v4u o; o.x = pk4_i8(s[0 * 33], s[1 * 33], s[2 * 33], s[3 * 33], qs); o.y = pk4_i8(s[4 * 33], s[5 * 33], s[6 * 33], s[7 * 33], qs);
        o.z = pk4_i8(s[8 * 33], s[9 * 33], s[10 * 33], s[11 * 33], qs); o.w = pk4_i8(s[12 * 33], s[13 * 33], s[14 * 33], s[15 * 33], qs);
        *(GAS v4u*)(WT + (size_t)n * K + k0 + 16 * c) = o; }
    LDS_WAIT(); asm volatile("" ::: "memory");
}
__device__ __forceinline__ void p0_prologue(Frame& F, const Args& a) {
    const int lane = lane_id();
    unsigned char* ws = a.ws;
    for (int it = blockIdx.x; it < 192; it += F.G) p0_ada_item(F, a.in[1], a.in[3], (float*)(ws + WS_ADAP), it);
    { const int gw0 = blockIdx.x * NWAVES + F.wave, n16 = lane & 15, g4 = lane >> 4;
      if (gw0 < 192) { const int w = gw0 / 24, s = (gw0 / 3) % 8, cb = gw0 % 3, n = 16 * cb + n16, k0 = 256 * w + 32 * s + 8 * g4;
          const float* pp = (n < 4) ? (a.in[19] + (size_t)k0 * 4 + n) : (a.in[21] + (size_t)k0 * 32 + ((n < 36) ? n - 4 : 0)); const int st = (n < 4) ? 4 : 32; const float vv = (n < 36) ? 1.f : 0.f;
          const v4u t = {cvt2bf(pp[0] * vv, pp[st] * vv), cvt2bf(pp[2 * st] * vv, pp[3 * st] * vv), cvt2bf(pp[4 * st] * vv, pp[5 * st] * vv), cvt2bf(pp[6 * st] * vv, pp[7 * st] * vv)};
          *(GAS v4u*)(ws + WS_FRAGR + ((size_t)gw0 * 64 + lane) * 16) = t; }
      else if (gw0 < 256) { const int i = gw0 - 192, w = i / 8, s = i % 8, k0 = 256 * w + 32 * s + 8 * g4; const float* pp = a.in[7] + (size_t)k0 * D_IN + NPROJ + n16;
          const v4u t = {cvt2bf(pp[0], pp[D_IN]), cvt2bf(pp[2 * D_IN], pp[3 * D_IN]), cvt2bf(pp[4 * D_IN], pp[5 * D_IN]), cvt2bf(pp[6 * D_IN], pp[7 * D_IN])};
          *(GAS v4u*)(ws + WS_FRAGZ + ((size_t)i * 64 + lane) * 16) = t; } }
    LAS float* scr = (LAS float*)(F.lds + RING_OFF + F.wave * 16384);
    const int gw = blockIdx.x * NWAVES + F.wave, NGW = F.G * NWAVES;
    constexpr int I_IN = (DM / 64) * (NPROJ / 32), I_OUT = (DM / 64) * (DM / 32), I_E = (DM / 64) * (DEXP / 32);
    constexpr int NITEMS = I_IN + I_OUT + 2 * NEXP * I_E;
    for (int it = gw; it < NITEMS; it += NGW) {
        int r = it;
        if (r < I_IN) { p0_colmax_item(a.in[7], NPROJ, D_IN, (unsigned*)(ws + WS_CTL) + CW_CMAX, r, lane); continue; } r -= I_IN;
        if (r < I_OUT) { p0_transpose_item(a.in[16], DM, DM, DM, (bf16*)(ws + WS_WOUT), 128, 0, scr, r, lane); continue; } r -= I_OUT;
        if (r < NEXP * I_E) { const int e = r / I_E; p0_transpose_item_f8(a.in[23] + (size_t)e * DM * DEXP, DM, DEXP, DEXP, (unsigned char*)(ws + WS_WUP) + (size_t)e * 1024 * DM, 256, 0, scr, r % I_E, lane); continue; } r -= NEXP * I_E;
        { const int e = r / I_E; p0_transpose_item_f8(a.in[24] + (size_t)e * DM * DEXP, DM, DEXP, DEXP, (unsigned char*)(ws + WS_WUP) + (size_t)e * 1024 * DM, 256, 128, scr, r % I_E, lane); }
    }
}

constexpr int T_STRIDE = 4112;
constexpr int P1_T = 0, P1_RED = 66048, P1_A1 = 74240, P1_A0 = 82432;
__device__ __forceinline__ void p1_prenorm(Frame& F, const Args& a) {
    const int lane = lane_id(), tid = F.wave * 64 + lane;
    const float* __restrict__ x = a.in[0]; const float* __restrict__ w_in = a.in[7]; const float* __restrict__ g = a.in[5];
    const float* part = (const float*)(a.ws + WS_ADAP); const float* b_ada = a.in[4];
    unsigned char* H = (unsigned char*)(a.ws + WS_H); float* RS = (float*)(a.ws + WS_RS); float* ZB = (float*)(a.ws + WS_ZB);
    LAS unsigned char* T = F.lds + RING_OFF + P1_T; LAS float* red = (LAS float*)(F.lds + RING_OFF + P1_RED);
    LAS float* A1 = (LAS float*)(F.lds + RING_OFF + P1_A1); LAS float* A0 = (LAS float*)(F.lds + RING_OFF + P1_A0);
    const int rows_per_blk = M / F.G, row_base = blockIdx.x * rows_per_blk, b = row_base / SEQ;
#pragma unroll
    for (int col_k = 0; col_k < DM / (NWAVES * 64); ++col_k) if (const int col = tid + col_k * NWAVES * 64; true) { const float sh = ada_get(part, b_ada, b, col), sc = ada_get(part, b_ada, b, DM + col); A1[col] = g[col] * (1.f + sc); A0[col] = sh; }
    const int n16 = lane & 15, g4 = lane >> 4;
    bf16x8 bz[8];
#pragma unroll
    for (int s = 0; s < 8; ++s) bz[s] = __builtin_bit_cast(bf16x8, *(const GAS v4u*)(a.ws + WS_FRAGZ + ((size_t)(F.wave * 8 + s) * 64 + lane) * 16));
    __syncthreads();
#define P1_LOAD(V, mrow) do { _Pragma("unroll") for (int j = 0; j < 8; ++j) V[j] = *(const GAS f32x4*)(x + (size_t)(mrow) * DM + 256 * j + 4 * lane); } while (0)
#define P1_PROC(V, mrow, lr) do { float ss = 0.f; \
        _Pragma("unroll") for (int j = 0; j < 8; ++j) ss += V[j].x * V[j].x + V[j].y * V[j].y + V[j].z * V[j].z + V[j].w * V[j].w; \
        const float r = rsqrtf(wave_sum(ss) * (1.f / DM) + EPS); \
        float am = 0.f; \
        _Pragma("unroll") for (int j = 0; j < 8; ++j) { const int col = 256 * j + 4 * lane; const f32x4 a1 = *(LAS f32x4*)(A1 + col), a0 = *(LAS f32x4*)(A0 + col); \
            const f32x4 h = V[j] * r * a1 + a0; V[j] = h; am = fmaxf(fmaxf(am, fmaxf(fabsf(h.x), fabsf(h.y))), fmaxf(fabsf(h.z), fabsf(h.w))); u32x2 o; o.x = pk2(h.x, h.y); o.y = pk2(h.z, h.w); \
            *(LAS u32x2*)(T + (lr) * T_STRIDE + col * 2) = o; } \
        am = fmaxf(wave_max(am), 1e-30f); const float qs = 127.f / am; \
        _Pragma("unroll") for (int j = 0; j < 8; ++j) *(GAS unsigned*)(H + (size_t)(mrow) * DM + 256 * j + 4 * lane) = pk4_i8(V[j].x, V[j].y, V[j].z, V[j].w, qs); \
        if (lane == 0) RS[mrow] = am * (1.f / 127.f); } while (0)
    f32x4 va[8], vb[8];
    P1_LOAD(va, row_base + 2 * F.wave);
    for (int t = 0; t < rows_per_blk / 16; ++t) {
        const int r0 = row_base + 16 * t;
        P1_LOAD(vb, r0 + 2 * F.wave + 1);
        P1_PROC(va, r0 + 2 * F.wave, 2 * F.wave);
        if (t + 1 < rows_per_blk / 16) P1_LOAD(va, r0 + 16 + 2 * F.wave);
        P1_PROC(vb, r0 + 2 * F.wave + 1, 2 * F.wave + 1);
        __syncthreads();
        f32x4 acc = (f32x4){0.f, 0.f, 0.f, 0.f};
#pragma unroll
        for (int s = 0; s < 8; ++s) { const bf16x8 af = *(LAS bf16x8*)(T + n16 * T_STRIDE + (256 * F.wave + 32 * s + 8 * g4) * 2); acc = __builtin_amdgcn_mfma_f32_16x16x32_bf16(af, bz[s], acc, 0, 0, 0); }
#pragma unroll
        for (int r = 0; r < 4; ++r) red[(F.wave * 16 + 4 * g4 + r) * 16 + n16] = acc[r];
        __syncthreads();
        if (tid < 256) { float s = 0.f;
#pragma unroll
            for (int w = 0; w < 8; ++w) s += red[w * 256 + tid];
            ZB[(size_t)(r0 + (tid >> 4)) * 16 + (tid & 15)] = s; }
    }
    __syncthreads();
#undef P1_LOAD
#undef P1_PROC
    { LAS float* scr = (LAS float*)(F.lds + RING_OFF + F.wave * 16384); const int gw = blockIdx.x * NWAVES + F.wave, NGW = F.G * NWAVES;
      for (int it = gw; it < (DM / 64) * (NPROJ / 32); it += NGW) p1_wq_item(w_in, DM, NPROJ, D_IN, (const unsigned*)(a.ws + WS_CTL) + CW_CMAX, a.ws + WS_WIN, scr, it, lane_id()); }
}


constexpr int P5_RED = 66048, P5_G1 = 90624, P5_B1 = 98816, P5_B0 = 107008, P5_LG = 115200;
__device__ __forceinline__ void p5_mid(Frame& F, const Args& a, int alt) {
    const int lane = lane_id(), tid = F.wave * 64 + lane;
    const float* __restrict__ x = a.in[0]; bf16* Y = (bf16*)(a.ws + WS_Y); unsigned char* H2 = (unsigned char*)(a.ws + WS_H2);
    const float* part = (const float*)(a.ws + WS_ADAP); const float* b_ada = a.in[4]; const float* g_post = a.in[6]; const float* g_pre = a.in[17];
    const float* __restrict__ w_rg = a.in[19]; const float* b_rg = a.in[20]; const float* __restrict__ w_re = a.in[21]; const float* b_re = a.in[22];
    unsigned* cnt = (unsigned*)(F.ctl + CW_CNT) + (alt ? 256 : 0) + 32 * (blockIdx.x & 7u); unsigned* list = (unsigned*)(a.ws + (alt ? WS_END : WS_LIST)); float* lw = (float*)(a.ws + (alt ? WS_END + 2 * MiB : WS_LW));
    LAS unsigned char* T = F.lds + RING_OFF; LAS float* red = (LAS float*)(F.lds + RING_OFF + P5_RED);
    LAS float* G1 = (LAS float*)(F.lds + RING_OFF + P5_G1); LAS float* B1 = (LAS float*)(F.lds + RING_OFF + P5_B1); LAS float* B0 = (LAS float*)(F.lds + RING_OFF + P5_B0); LAS float* lg = (LAS float*)(F.lds + RING_OFF + P5_LG);
    const int rows_per_blk = M / F.G, row_base = blockIdx.x * rows_per_blk, b = row_base / SEQ;
#pragma unroll 2
    for (int col_k = 0; col_k < DM / (NWAVES * 64); ++col_k) if (const int col = tid + col_k * NWAVES * 64; true) { const float gt = ada_get(part, b_ada, b, 2 * DM + col), sh = ada_get(part, b_ada, b, 3 * DM + col), sc = ada_get(part, b_ada, b, 4 * DM + col);
        G1[col] = gt * g_post[col]; B1[col] = g_pre[col] * (1.f + sc); B0[col] = sh; }
    const int n16 = lane & 15, g4 = lane >> 4;
    bf16x8 bw[8][3];
#pragma unroll
    for (int s = 0; s < 8; ++s)
#pragma unroll
        for (int cb = 0; cb < 3; ++cb) bw[s][cb] = __builtin_bit_cast(bf16x8, *(const GAS v4u*)(a.ws + WS_FRAGR + ((size_t)((F.wave * 8 + s) * 3 + cb) * 64 + lane) * 16));
    __syncthreads();
#define P5_LOAD(YW, mrow) do { _Pragma("unroll") for (int j = 0; j < 8; ++j) YW[j] = *(const GAS u32x2*)(Y + (size_t)(mrow) * DM + 256 * j + 4 * lane); } while (0)
#define P5_PROC(YW, mrow, lr) do { f32x4 xv[8], XV[8]; float ss = 0.f; \
        _Pragma("unroll") for (int j = 0; j < 8; ++j) XV[j] = *(const GAS f32x4*)(x + (size_t)(mrow) * DM + 256 * j + 4 * lane); \
        _Pragma("unroll") for (int j = 0; j < 8; ++j) { const u32x2 w = YW[j]; \
            xv[j] = (f32x4){__uint_as_float(w.x << 16), __uint_as_float(w.x & 0xffff0000u), __uint_as_float(w.y << 16), __uint_as_float(w.y & 0xffff0000u)}; \
            ss += xv[j].x * xv[j].x + xv[j].y * xv[j].y + xv[j].z * xv[j].z + xv[j].w * xv[j].w; } \
        const float ry = rsqrtf(wave_sum(ss) * (1.f / DM) + EPS); float ss2 = 0.f; \
        _Pragma("unroll") for (int j = 0; j < 8; ++j) { const int col = 256 * j + 4 * lane; const f32x4 g1 = *(LAS f32x4*)(G1 + col); \
            xv[j] = XV[j] + g1 * (xv[j] * ry); { u32x2 o1; o1.x = cvt2bf(xv[j].x, xv[j].y); o1.y = cvt2bf(xv[j].z, xv[j].w); *(GAS u32x2*)(Y + (size_t)(mrow) * DM + col) = o1; } \
            ss2 += xv[j].x * xv[j].x + xv[j].y * xv[j].y + xv[j].z * xv[j].z + xv[j].w * xv[j].w; } \
        const float rx = rsqrtf(wave_sum(ss2) * (1.f / DM) + EPS); \
        _Pragma("unroll") for (int j = 0; j < 8; ++j) { const int col = 256 * j + 4 * lane; const f32x4 b1 = *(LAS f32x4*)(B1 + col), b0 = *(LAS f32x4*)(B0 + col); \
            const f32x4 h = xv[j] * rx * b1 + b0; u32x2 o; o.x = pk2(h.x, h.y); o.y = pk2(h.z, h.w); \
            *(GAS unsigned*)(H2 + (size_t)(mrow) * DM + col) = pk4_fp8(h.x, h.y, h.z, h.w); *(LAS u32x2*)(T + (lr) * T_STRIDE + col * 2) = o; } } while (0)
    u32x2 ya[8], yb[8];
    P5_LOAD(ya, row_base + 2 * F.wave);
    for (int t = 0; t < rows_per_blk / 16; ++t) {
        const int r0 = row_base + 16 * t;
        P5_LOAD(yb, r0 + 2 * F.wave + 1);
        P5_PROC(ya, r0 + 2 * F.wave, 2 * F.wave);
        if (t + 1 < rows_per_blk / 16) P5_LOAD(ya, r0 + 16 + 2 * F.wave);
        P5_PROC(yb, r0 + 2 * F.wave + 1, 2 * F.wave + 1);
        __syncthreads();
        f32x4 acc[3];
#pragma unroll
        for (int cb = 0; cb < 3; ++cb) acc[cb] = (f32x4){0.f, 0.f, 0.f, 0.f};
#pragma unroll
        for (int s = 0; s < 8; ++s) { const bf16x8 af = *(LAS bf16x8*)(T + n16 * T_STRIDE + (256 * F.wave + 32 * s + 8 * g4) * 2);
#pragma unroll
            for (int cb = 0; cb < 3; ++cb) acc[cb] = __builtin_amdgcn_mfma_f32_16x16x32_bf16(af, bw[s][cb], acc[cb], 0, 0, 0); }
#pragma unroll
        for (int cb = 0; cb < 3; ++cb)
#pragma unroll
            for (int r = 0; r < 4; ++r) red[(F.wave * 16 + 4 * g4 + r) * 48 + 16 * cb + n16] = acc[cb][r];
        __syncthreads();
        for (int o = tid; o < 768; o += NWAVES * 64) { float s = 0.f; const int n = o % 48;
#pragma unroll
            for (int w = 0; w < 8; ++w) s += red[w * 768 + o];
            lg[t * 768 + o] = s + ((n < 4) ? b_rg[n] : ((n < 36) ? b_re[n - 4] : 0.f)); }
    }
    LAS unsigned* lcnt = (LAS unsigned*)(F.lds + RING_OFF + P5_RED);
    __syncthreads();
    if (tid < 64) lcnt[tid] = 0u;
    __syncthreads();
    unsigned ea = 0u, eb = 0u, pa = 0u, pb = 0u; float wa_ = 0.f, wb_ = 0.f;
    if (tid < rows_per_blk) {
        const LAS float* L = lg + tid * 48;
        int gi = 0; float gm = L[0];
        for (int i = 1; i < 4; ++i) if (L[i] > gm) { gm = L[i]; gi = i; }
        float gs = 0.f; for (int i = 0; i < 4; ++i) gs += __expf(L[i] - gm);
        const float gval = 1.f / gs;
        const LAS float* E = L + 4 + 8 * gi;
        int e1 = 0; float m1 = E[0];
        for (int i = 1; i < 8; ++i) if (E[i] > m1) { m1 = E[i]; e1 = i; }
        int e2 = 0; float m2 = -3.0e38f;
        for (int i = 0; i < 8; ++i) if (i != e1 && E[i] > m2) { m2 = E[i]; e2 = i; }
        const float p2 = __expf(m2 - m1), inv = 1.f / (1.f + p2);
        ea = (unsigned)(gi * 8 + e1); eb = (unsigned)(gi * 8 + e2); wa_ = gval * inv; wb_ = gval * p2 * inv;
        pa = __hip_atomic_fetch_add(lcnt + ea, 1u, __ATOMIC_RELAXED, __HIP_MEMORY_SCOPE_WORKGROUP); pb = __hip_atomic_fetch_add(lcnt + eb, 1u, __ATOMIC_RELAXED, __HIP_MEMORY_SCOPE_WORKGROUP);
    }
    __syncthreads();
    if (tid < 32) { const unsigned c = lcnt[tid]; lcnt[32 + tid] = c ? atomicAdd(&cnt[tid], c) : 0u; }
    __syncthreads();
    if (tid < rows_per_blk) { const int m = row_base + tid; pa += lcnt[32 + ea] + 2048u * (blockIdx.x & 7u); pb += lcnt[32 + eb] + 2048u * (blockIdx.x & 7u);
        list[(size_t)ea * LISTCAP + pa] = (unsigned)(m * 2); lw[(size_t)ea * LISTCAP + pa] = wa_;
        list[(size_t)eb * LISTCAP + pb] = (unsigned)(m * 2 + 1); lw[(size_t)eb * LISTCAP + pb] = wb_; }
    __syncthreads();
#undef P5_LOAD
#undef P5_PROC
}


__device__ __forceinline__ int q_steal(gu32* qh, int x0, int nq) {
    unsigned hd[8];
#pragma unroll
    for (int k = 1; k < 8; ++k) hd[k] = __hip_atomic_load(qh + 64 * ((x0 + k) & 7), __ATOMIC_RELAXED, __HIP_MEMORY_SCOPE_AGENT);
#pragma unroll
    for (int k = 1; k < 8; ++k) { const int x = (x0 + k) & 7; if (hd[k] >= (unsigned)nq) continue;
        const unsigned id = __hip_atomic_fetch_add(qh + 64 * x, 1u, __ATOMIC_RELAXED, __HIP_MEMORY_SCOPE_AGENT); if (id < (unsigned)nq) return x * 256 + (int)id; }
    return -1;
}
__device__ __forceinline__ int q_pop(gu32* qh, int x0, int nq) {
    const unsigned id = __hip_atomic_fetch_add(qh + 64 * (x0 & 7), 1u, __ATOMIC_RELAXED, __HIP_MEMORY_SCOPE_AGENT); if (id < (unsigned)nq) return (x0 & 7) * 256 + (int)id;
    return q_steal(qh, x0, nq);
}
constexpr int CW_W2 = 1024;
__device__ __forceinline__ void p6_tail_w2(Frame& F, const Args& a) {
    const int lane = lane_id(), tid = F.wave * 64 + lane;
    LAS float* scr = (LAS float*)(F.lds + RING_OFF + F.wave * 16384);
    constexpr int I_E = (DEXP / 64) * (DM / 32), NBI = NEXP * I_E / NWAVES;
    const int x0 = (int)(blockIdx.x & 7u); gu32* qh = F.ctl + CW_W2;
    if (tid == 0) F.MISC[16] = (unsigned)q_pop(qh, x0, NBI / 8);
    __syncthreads();
    int it = (int)F.MISC[16]; bool own = true;
    __syncthreads();
    while (it >= 0) {
        unsigned idn = 0xffffffffu;
        if (tid == 0 && own) idn = __hip_atomic_fetch_add(qh + 64 * x0, 1u, __ATOMIC_RELAXED, __HIP_MEMORY_SCOPE_AGENT);
        { const int r = it * NWAVES + F.wave, e = r / I_E;
          p0_transpose_item_f8(a.in[25] + (size_t)e * DM * DEXP, DEXP, DM, DM, (unsigned char*)(a.ws + WS_WDN) + (size_t)e * DM * DEXP, 128, 0, scr, r % I_E, lane); }
        if (tid == 0) { int got = -1; if (own) { if (idn < (unsigned)(NBI / 8)) got = x0 * 256 + (int)idn; else own = false; } if (got < 0) got = q_steal(qh, x0, NBI / 8); F.MISC[16] = (unsigned)got; }
        __syncthreads();
        it = (int)F.MISC[16];
        __syncthreads();
    }
}

constexpr int TAB_OFF = MISC_OFF + 128;
static_assert(TAB_OFF % 16 == 0 && TAB_OFF + 192 + 2 * pg8::MOE_MAXU * 1024 <= LDS_BYTES, "LDS tables");
__device__ __forceinline__ void moe_tables(Frame& F, const Args& a, int NJ, bool down) {
    const int tid = F.wave * 64 + lane_id();
    const unsigned* cnt = (const unsigned*)(F.ctl + CW_CNT); const unsigned* list = (const unsigned*)(a.ws + WS_LIST); const float* lw = (const float*)(a.ws + WS_LW);
    LAS unsigned* tstart = (LAS unsigned*)(F.lds + TAB_OFF); LAS unsigned* rowmap = tstart + 48; LAS float* cwt = (LAS float*)(rowmap + pg8::MOE_MAXU * 256);
    LAS unsigned* sub = (LAS unsigned*)(F.lds + RING_OFF); LAS unsigned* tot = sub + 256;
    if (tid < 256) sub[tid] = cnt[tid];
    __syncthreads();
    if (tid < 32) { unsigned n = 0; for (int j = 0; j < 8; ++j) n += sub[32 * j + tid]; tot[tid] = n; }
    __syncthreads();
    if (tid == 0) { unsigned s = 0; for (int e = 0; e < NEXP; ++e) { tstart[e] = s; s += (tot[e] + 255u) >> 8; } tstart[32] = s;
        unsigned ok = 0u;
        tstart[33] = ok; }
    __syncthreads();
    unsigned idx[3], ent[3]; float wv[3]; bool val[3], has[3];
#pragma unroll
    for (int k = 0; k < 3; ++k) { has[k] = false; val[k] = false; idx[k] = 0u; }
#pragma unroll
    for (int i = 0; i < pg8::MOE_MAXU; ++i) {
        int tt, pn, e; const bool ok = pg8::moe_unit((const LAS unsigned*)tstart, NJ, F.G, (int)blockIdx.x, i, tt, pn, e);
        if (ok && (i & 1) == (tid >> 8)) { const int k = i >> 1; const unsigned n = tot[e];
            const unsigned slot = (unsigned)(tt - (int)tstart[e]) * 256u + (unsigned)(tid & 255); const bool valid = slot < n; unsigned sl = valid ? slot : n - 1u, base = 0u;
#pragma unroll
            for (int j = 0; j < 7; ++j) { const unsigned cj = sub[32 * j + e]; const bool nxt = sl >= cj && base == 2048u * j; if (nxt) { sl -= cj; base += 2048u; } }
            has[k] = true; val[k] = valid; idx[k] = (unsigned)e * (unsigned)LISTCAP + sl + base; }
    }
#pragma unroll
    for (int k = 0; k < 3; ++k) { ent[k] = has[k] ? list[idx[k]] : 0u; wv[k] = has[k] ? lw[idx[k]] : 0.f; }
#pragma unroll
    for (int k = 0; k < 3; ++k) if (has[k]) { const int i = 2 * k + (tid >> 8), r = tid & 255;
        rowmap[i * 256 + r] = down ? (val[k] ? (ent[k] & 1u) * (unsigned)M + (ent[k] >> 1) : 0xffffffffu) : (ent[k] >> 1);
        cwt[i * 256 + r] = val[k] ? wv[k] : 0.f; }
    __syncthreads();
}

__device__ __forceinline__ void p8_final(Frame& F, const Args& a, int dummy) {
    const int lane = lane_id(), tid = F.wave * 64 + lane;
    const unsigned char* __restrict__ Y2 = (const unsigned char*)(a.ws + WS_Y2); const bf16* __restrict__ X1 = (const bf16*)(a.ws + WS_Y); float* outw = dummy ? (float*)(a.ws + WS_WUP) : a.out; const float* part = (const float*)(a.ws + WS_ADAP); const float* b_ada = a.in[4]; const float* g_post = a.in[18];
    LAS float* G1 = (LAS float*)(F.lds + RING_OFF);
    const int rows_per_blk = M / F.G, row_base = blockIdx.x * rows_per_blk, b = row_base / SEQ;
#pragma unroll
    for (int col_k = 0; col_k < DM / (NWAVES * 64); ++col_k) if (const int col = tid + col_k * NWAVES * 64; true) G1[col] = ada_get(part, b_ada, b, 5 * DM + col) * g_post[col];
    __syncthreads();
#define P8_LOAD(W0, W1, OV, mrow) do { _Pragma("unroll") for (int j = 0; j < 8; ++j) { const int col = 256 * j + 4 * lane; W0[j] = *(const GAS unsigned*)(Y2 + (size_t)(mrow) * DM + col); \
        W1[j] = *(const GAS unsigned*)(Y2 + ((size_t)M + (mrow)) * DM + col); OV[j] = *(const GAS u32x2*)(X1 + (size_t)(mrow) * DM + col); } } while (0)
#define P8_PROC(W0, W1, OV, mrow) do { f32x4 yv[8]; float ss = 0.f; \
        _Pragma("unroll") for (int j = 0; j < 8; ++j) { const cf32x2_t a0_ = __builtin_amdgcn_cvt_pk_f32_fp8((int)W0[j], false), a1_ = __builtin_amdgcn_cvt_pk_f32_fp8((int)W0[j], true), \
                b0_ = __builtin_amdgcn_cvt_pk_f32_fp8((int)W1[j], false), b1_ = __builtin_amdgcn_cvt_pk_f32_fp8((int)W1[j], true); \
            yv[j] = (f32x4){a0_[0] + b0_[0], a0_[1] + b0_[1], a1_[0] + b1_[0], a1_[1] + b1_[1]} * (1.f / F8_YSCALE); \
            ss += yv[j].x * yv[j].x + yv[j].y * yv[j].y + yv[j].z * yv[j].z + yv[j].w * yv[j].w; } \
        const float r = rsqrtf(wave_sum(ss) * (1.f / DM) + EPS); \
        _Pragma("unroll") for (int j = 0; j < 8; ++j) { const int col = 256 * j + 4 * lane; const f32x4 g1 = *(LAS f32x4*)(G1 + col); const u32x2 xw = OV[j]; const f32x4 x1v = (f32x4){__uint_as_float(xw.x << 16), __uint_as_float(xw.x & 0xffff0000u), __uint_as_float(xw.y << 16), __uint_as_float(xw.y & 0xffff0000u)}; \
            *(GAS f32x4*)(outw + (size_t)(mrow) * DM + col) = x1v + g1 * (yv[j] * r); } } while (0)
    { unsigned a0[8], a1[8], b0[8], b1[8]; u32x2 ao[8], bo[8];
      const int m0 = row_base + F.wave, npair = rows_per_blk / (2 * NWAVES);
      P8_LOAD(a0, a1, ao, m0);
#pragma unroll 1
      for (int it = 0; it < npair; ++it) {
          P8_LOAD(b0, b1, bo, m0 + NWAVES * (2 * it + 1));
          P8_PROC(a0, a1, ao, m0 + NWAVES * (2 * it));
          if (it + 1 < npair) P8_LOAD(a0, a1, ao, m0 + NWAVES * (2 * it + 2));
          P8_PROC(b0, b1, bo, m0 + NWAVES * (2 * it + 1));
      } }
#undef P8_LOAD
#undef P8_PROC
    __syncthreads();
}


constexpr int CW_GF = 65536;
constexpr int CW_Q = 2048;
constexpr int NQ_ATT = 158;
__device__ __forceinline__ void p3_mixer(Frame& F, const Args& a, LAS char* ldsg, int qset, int mode, int abl) {
    const int tid = F.wave * 64 + lane_id();
    const bf16* P = (const bf16*)(a.ws + WS_PROJ); bf16* CAT = (bf16*)(a.ws + WS_CAT);
    const float* rel_bias = a.in[2];
    LAS float* tab = (LAS float*)(ldsg + att::OFF_TAB); LAS float* miscf = (LAS float*)(ldsg + att::OFF_MISC); LAS int* qw = (LAS int*)(ldsg + att::OFF_MISC + 16);
    { LAS float* rbl = (LAS float*)ldsg;
      if (tid < 256) rbl[tid] = rel_bias[tid];
      __syncthreads();
      for (int idx = tid; idx < 8 * att::TABN; idx += NWAVES * 64) { const int h = idx / att::TABN; int rel = idx % att::TABN - att::TOFF; rel = rel < -256 ? -256 : rel;
        tab[idx] = rbl[t5_bucket(rel) * 8 + h] * LOG2E; } }
    const int x0 = (int)(xb_xcc_id() & 7u);
    if (tid < 64) { const float d1 = wave_sum(a.in[10][tid] * a.in[11][tid]), d2 = wave_sum(a.in[12][tid] * a.in[13][tid]);
        if (tid == 0) miscf[0] = __expf(d1) - __expf(d2) + LAM_INIT; }
    if (tid == 0) { qw[0] = q_pop(F.ctl + CW_Q + 512 * qset, x0, (mode == 1) ? 128 : ((mode == 2) ? 30 : ((mode == 3) ? 64 : NQ_ATT))); }
    __syncthreads();
    int cur = qw[0], par = 1;
    {
        gu32* qh = F.ctl + CW_Q + 512 * qset; const int nq = (mode == 1) ? 128 : ((mode == 2) ? 30 : ((mode == 3) ? 64 : NQ_ATT));
        unsigned char* GS = a.ws + WS_GLA; unsigned* gfl = (unsigned*)(F.ctl + CW_GF) + 8192 * qset; unsigned* tmo = (unsigned*)(F.ctl + CW_BAR) + XB_TMO;
        while (cur >= 0) {
            if (tid == 0) qw[par] = q_pop(qh, x0, nq);
            const int x = cur >> 8, id = cur & 255;
            int kind, k;
            if (mode == 1 || mode == 3) { kind = 2; k = id; } else if (mode == 2) { kind = id < 14 ? 0 : 1; k = id < 14 ? id : id - 14; }
            else if (id < 14) { kind = 0; k = id; } else if (id < 46) { kind = 2; k = id - 14; } else if (id < 62) { kind = 1; k = id - 46; } else { kind = 2; k = id - 30; }
            if (kind == 2) { const int u = 31 - (k >> 2), bh = x * 4 + (k & 3);
#if defined(PROBE_ABL) && PROBE_ABL != 0
                if (abl) att::attn_unit<PROBE_ABL>(P, (bf16*)(a.ws + WS_END), a.in[14], bh >> 3, bh & 7, u, F.wave, ldsg); else
#endif
                att::attn_unit<0>(P, CAT, a.in[14], bh >> 3, bh & 7, u, F.wave, ldsg); }
            else { const int gid = 2 * x + (kind ? (k >> 3) : (k / 7)), grp = kind ? (k & 7) : (k % 7);
                gla::gla_unit(P, (const float*)(a.ws + WS_ZB), a.in[8], a.in[9], a.in[15], CAT, gid >> 2, gid & 3, grp, kind, GS + (size_t)qset * 0, gfl, tmo, F.wave, ldsg); }
            cur = qw[par]; par ^= 1;
        }
    }
    __syncthreads();
}

__global__ void __launch_bounds__(NWAVES * 64, 2) mega_fwd(Args args) {
    extern __shared__ __attribute__((aligned(16))) unsigned char lds[];
    Frame F;
    F.lds = (LAS unsigned char*)lds;
    F.MISC = (volatile LAS unsigned*)(F.lds + MISC_OFF);
    F.wave = __builtin_amdgcn_readfirstlane((int)threadIdx.x >> 6);
    F.G = gridDim.x;
    unsigned char* ws = args.ws;
    F.ctl = (gu32*)(ws + WS_CTL);
    { const int tid = F.wave * 64 + lane_id(); for (int u = tid; u < (LDS_BYTES - LDSCTL_OFF) / 4; u += NWAVES * 64) ((LAS unsigned*)(F.lds + LDSCTL_OFF))[u] = 0u; }
    __syncthreads();
    const int lo = args.ph_lo, hi = args.ph_hi;
    const bool use_bar = (hi - lo) > 1;
    XcdBarrier bar; bar.bar = (unsigned*)(F.ctl + CW_BAR) + args.li * XCD_BAR_WORDS; bar.x = 0; bar.st = nullptr;
    if (use_bar) bar = xcd_barrier_post((unsigned*)(F.ctl + CW_BAR) + args.li * XCD_BAR_WORDS, F.MISC + 8, F.wave == 0 && lane_id() == 0);
#define IN(k) (lo <= (k) && (k) < hi)
#define BOTH(k) (IN(k) && IN((k) + 1))
#ifdef PROBE_BAR2
#define GRID_BAR() do { xcd_barrier(bar, F.wave == 0 && lane_id() == 0); xcd_barrier(bar, F.wave == 0 && lane_id() == 0); xcd_barrier(bar, F.wave == 0 && lane_id() == 0); } while (0)
#else
#define GRID_BAR() xcd_barrier(bar, F.wave == 0 && lane_id() == 0)
#endif
#ifndef PROBE_DUP
#define PROBE_DUP (-1)
#endif
#define NREP(k) ((PROBE_DUP == (k)) ? 2 : 1)
#define REP(k) for (int rep_ = 0; rep_ < NREP(k); ++rep_)
#define SEAM(k) do { if (BOTH(k) || rep_ + 1 < NREP(k)) GRID_BAR(); } while (0)
    if (IN(0)) REP(0) { p0_prologue(F, args); SEAM(0); }
    if (IN(1)) REP(1) { p1_prenorm(F, args); SEAM(1); }
    if (IN(2)) REP(2) {
        pg8::Gemm g{(const bf16*)(ws + WS_H), (const bf16*)(ws + WS_WIN), M, NPROJ, DM / 2}; pg8::StaticOrderG S; S.init(M, NPROJ, F.G, (int)blockIdx.x);
        pg8::EpiProjQ E{(bf16*)(ws + WS_PROJ), NPROJ, (const float*)(ws + WS_RS), (const unsigned*)(ws + WS_CTL) + CW_CMAX};
        pg8::gemm_phase_g<pg8::EpiProjQ, pg8::StaticOrderG, 2>(F.lds + RING_OFF, g, S, E, F.wave);
        SEAM(2);
    }
    if (IN(3)) REP(3) { p3_mixer(F, args, (LAS char*)(F.lds + RING_OFF), (args.pad & 3) + rep_, (args.pad >> 2) & 3, args.pad >> 4); SEAM(3); }
    if (IN(4)) REP(4) {
        pg8::Gemm g{(const bf16*)(ws + WS_CAT), (const bf16*)(ws + WS_WOUT), M, DM, DM}; pg8::StaticOrderG S; S.init(M, DM, F.G, (int)blockIdx.x);
        pg8::EpiPlain E{(bf16*)(ws + WS_Y), DM};
        pg8::gemm_phase_g<pg8::EpiPlain, pg8::StaticOrderG, 0>(F.lds + RING_OFF, g, S, E, F.wave);
        SEAM(4);
    }
    if (IN(5)) REP(5) { p5_mid(F, args, NREP(5) - 1 - rep_); SEAM(5); }
    if (IN(6)) REP(6) {
        moe_tables(F, args, 4, false);
        const pg8::Gemm g{(const bf16*)(ws + WS_H2), (const bf16*)(ws + WS_WUP), 0, 0, DM / 2};
        const pg8::MoeOrder S{(const LAS unsigned*)(F.lds + TAB_OFF), (const LAS unsigned*)(F.lds + TAB_OFF + 192), 4, F.G, (int)blockIdx.x, true, (size_t)1024 * DM};
        const pg8::EpiUp E{(unsigned char*)(ws + WS_HID), (const LAS float*)(F.lds + TAB_OFF + 192 + pg8::MOE_MAXU * 1024)};
        pg8::gemm_phase_g<pg8::EpiUp, pg8::MoeOrder, true>(F.lds + RING_OFF, g, S, E, F.wave);
        p6_tail_w2(F, args);
        SEAM(6);
    }
    if (IN(7)) REP(7) {
        moe_tables(F, args, 8, true);
        const pg8::Gemm g{(const bf16*)(ws + WS_HID), (const bf16*)(ws + WS_WDN), 0, 0, DEXP / 2};
        const pg8::MoeOrder S{(const LAS unsigned*)(F.lds + TAB_OFF), (const LAS unsigned*)(F.lds + TAB_OFF + 192), 8, F.G, (int)blockIdx.x, false, (size_t)DM * DEXP};
        const pg8::EpiDown E{(unsigned char*)(ws + WS_Y2), (const LAS unsigned*)(F.lds + TAB_OFF + 192)};
        pg8::gemm_phase_g<pg8::EpiDown, pg8::MoeOrder, true>(F.lds + RING_OFF, g, S, E, F.wave);
        SEAM(7);
    }
    if (IN(8)) REP(8) { p8_final(F, args, NREP(8) - 1 - rep_); SEAM(8); }
#undef IN
#undef BOTH
}
static void launch_mega(const Args& a0, int lo, int hi, int li, int grid, hipStream_t stream, int p3opt = 0) {
    Args a = a0; a.ph_lo = lo; a.ph_hi = hi; a.li = li; a.pad = p3opt;
    hipLaunchKernelGGL(mega_fwd, dim3(grid), dim3(NWAVES * 64), LDS_BYTES, stream, a);
    const hipError_t le = hipPeekAtLastError();
    if (le != hipSuccess) fprintf(stderr, "kernel_launch: mega launch [%d,%d) failed: %s\n", lo, hi, hipGetErrorName(le));
}
extern "C" void kernel_launch(void* const* d_in, const int* in_sizes, int n_in, void* d_out, int out_size, void* d_ws, size_t ws_size, hipStream_t stream) {
    static int grid = 0;
    if (grid == 0) {
        if (n_in != 26 || in_sizes[0] != M * DM || out_size != M * DM || ws_size < WS_END) { fprintf(stderr, "kernel_launch: unexpected shapes (n_in %d, in0 %d, out %d, ws %zu < %zu)\n", n_in, n_in > 0 ? in_sizes[0] : -1, out_size, ws_size, (size_t)WS_END); grid = -1; return; }
        int dev = 0, cus = 0;
        if (hipGetDevice(&dev) != hipSuccess || hipDeviceGetAttribute(&cus, hipDeviceAttributeMultiprocessorCount, dev) != hipSuccess) { grid = -1; return; }
        if (hipFuncSetAttribute((const void*)mega_fwd, hipFuncAttributeMaxDynamicSharedMemorySize, LDS_BYTES) != hipSuccess) { fprintf(stderr, "kernel_launch: hipFuncSetAttribute failed\n"); grid = -1; return; }
        int per_cu = 0;
        if (hipOccupancyMaxActiveBlocksPerMultiprocessor(&per_cu, (const void*)mega_fwd, NWAVES * 64, LDS_BYTES) != hipSuccess || per_cu < 1) fprintf(stderr, "kernel_launch: occupancy query reports %d\n", per_cu);
        (void)hipGetLastError();
        grid = cus;
        if (grid != 256) { fprintf(stderr, "kernel_launch: built for 256 CUs, found %d\n", cus); grid = -1; return; }
    }
    if (grid < 0) return;
    const float* x = (const float*)d_in[0]; const float* rel_bias = (const float*)d_in[2]; const float* b_ada = (const float*)d_in[4];
    const float* g_post_mix = (const float*)d_in[6]; const float* w_alpha = (const float*)d_in[8]; const float* b_alpha = (const float*)d_in[9];
    const float* lq1 = (const float*)d_in[10]; const float* lk1 = (const float*)d_in[11]; const float* lq2 = (const float*)d_in[12]; const float* lk2 = (const float*)d_in[13];
    const float* g_sub_a = (const float*)d_in[14]; const float* g_norm_b = (const float*)d_in[15]; const float* g_pre_ffn = (const float*)d_in[17]; const float* g_post_ffn = (const float*)d_in[18];
    const float* w_rg = (const float*)d_in[19]; const float* b_rg = (const float*)d_in[20]; const float* w_re = (const float*)d_in[21]; const float* b_re = (const float*)d_in[22];
    char* ws = (char*)d_ws; float* out = (float*)d_out;
    unsigned* cnt = (unsigned*)(ws + WS_CTL); float* adap = (float*)(ws + WS_ADAP); float* ZB = (float*)(ws + WS_ZB); unsigned* list = (unsigned*)(ws + WS_LIST); float* lw = (float*)(ws + WS_LW);
    bf16* Wup = (bf16*)(ws + WS_WUP); bf16* Wdn = (bf16*)(ws + WS_WDN);
    bf16* CAT = (bf16*)(ws + WS_CAT); bf16* PROJ = (bf16*)(ws + WS_PROJ); bf16* Y = (bf16*)(ws + WS_Y); bf16* H2 = (bf16*)(ws + WS_H2); bf16* Y2 = (bf16*)(ws + WS_Y2); bf16* HID = (bf16*)(ws + WS_HID);
    (void)hipMemsetAsync(ws + WS_CTL, 0, 1 * MiB, stream);
    Args a{};
    for (int i = 0; i < 26; ++i) a.in[i] = (const float*)d_in[i];
    a.out = out; a.ws = (unsigned char*)d_ws;
#ifndef PROBE_LAUNCHES
    launch_mega(a, 0, N_PHASES, 0, grid, stream);
#else
    for (int p = 0; p < N_PHASES; ++p) { launch_mega(a, p, p + 1, p, grid, stream);
        if (p == 3 && PROBE_LAUNCHES > 0) launch_mega(a, 3, 4, 9, grid, stream, 1 + 4 * ((PROBE_LAUNCHES - 1) & 3) + 16 * ((PROBE_LAUNCHES - 1) >> 2)); }
#endif
}
```
